# Optimizing an MI355X kernel written in HIP

```python
import jax, jax.numpy as jnp
from jax import lax
import numpy as np

D_MODEL = 1024
BATCH = 16
SEQ = 4096
DEPTH = 2
DEC_BATCH = 4
DEC_SEQ = 4096
PAST_LEN = 128

HEAD_DIM = 64
N_HEADS_A = 8
N_HEADS_B = 8
N_KV_B = 2
MIX_WIDTH = (N_HEADS_A + N_HEADS_B) * HEAD_DIM
DILATED_PAIRS = ((128, 1), (512, 4), (2048, 16))
WINDOW_B = 128
D_FF = 2816
N_BUCKETS = 32
MAX_DISTANCE = 1024
EPS = 1e-6
NEG_INF = -1e30
IN_WIDTHS = (N_HEADS_A * HEAD_DIM, N_HEADS_A * HEAD_DIM, N_HEADS_A * HEAD_DIM,
             N_HEADS_B * HEAD_DIM, N_KV_B * HEAD_DIM, N_KV_B * HEAD_DIM)
W_IN_COLS = sum(IN_WIDTHS)

kernel_name = 'hybrid_dilated_window_encoder'


def rms_norm(x, g):
    x32 = x.astype(jnp.float32)
    y = x32 * lax.rsqrt(jnp.mean(x32 * x32, axis=-1, keepdims=True) + EPS)
    return (y * g.astype(jnp.float32)).astype(x.dtype)


def swiglu(x, w_gate, w_up, w_down):
    return (jax.nn.silu(x @ w_gate) * (x @ w_up)) @ w_down


def _rel_bucket(rel):
    nb = N_BUCKETS // 2
    max_exact = nb // 2
    n = np.abs(rel)
    large = max_exact + (np.log(np.maximum(n, 1).astype(np.float32) / max_exact)
                         / np.log(MAX_DISTANCE / max_exact) * (nb - max_exact)).astype(np.int32)
    large = np.minimum(large, nb - 1)
    return ((rel > 0).astype(np.int32) * nb + np.where(n < max_exact, n, large)).astype(np.int32)


def _band_bias(rel_table, head_lo, n_heads, win, dilation):
    qq = np.arange(win)[:, None]
    kk = np.arange(3 * win)[None, :]
    bucket = jnp.asarray(_rel_bucket((kk - win - qq) * dilation))
    b = rel_table[:, head_lo:head_lo + n_heads][bucket]
    return jnp.transpose(b, (2, 0, 1))


def band_attention(q, k, v, bias, win, sink=None):
    B, L, Hq, dh = q.shape
    Hk = k.shape[2]
    G = Hq // Hk
    nblk = -(-L // win)
    Lp = nblk * win
    qp = jnp.pad(q, ((0, 0), (0, Lp - L), (0, 0), (0, 0))).reshape(B, nblk, win, Hk, G, dh)
    pad_kv = ((0, 0), (win, Lp - L + win), (0, 0), (0, 0))

    def blocks3(t):
        t = jnp.pad(t, pad_kv).reshape(B, nblk + 2, win, Hk, dh)
        return jnp.concatenate([t[:, :-2], t[:, 1:-1], t[:, 2:]], axis=2)

    kb, vb = blocks3(k), blocks3(v)
    s = jnp.einsum('bnqhgd,bnkhd->bnhgqk', qp, kb, preferred_element_type=jnp.float32) * (dh ** -0.5)
    s = s + bias.reshape(Hk, G, win, 3 * win).astype(jnp.float32)
    qq = np.arange(win)[:, None]
    kk = np.arange(3 * win)[None, :]
    band = np.abs(kk - win - qq) <= win
    kpos = np.arange(nblk)[:, None] * win + kk - win
    inside = (kpos >= 0) & (kpos < L)
    mask = jnp.asarray(band[None, :, :] & inside[:, None, :])
    s = jnp.where(mask[None, :, None, None], s, NEG_INF)
    m = jnp.max(s, axis=-1)
    if sink is not None:
        sink_l = sink.astype(jnp.float32).reshape(Hk, G, 1)
        m = jnp.maximum(m, sink_l)
    p = jnp.exp(s - m[..., None])
    denom = jnp.sum(p, axis=-1)
    if sink is not None:
        denom = denom + jnp.exp(sink_l - m)
    o = jnp.einsum('bnhgqk,bnkhd->bnqhgd', (p / denom[..., None]).astype(v.dtype), vb)
    o = o.reshape(B, Lp, Hq, dh)[:, :L]
    lse = jnp.transpose(m + jnp.log(denom), (0, 1, 4, 2, 3)).reshape(B, Lp, Hq)[:, :L]
    return o, lse


def dilated_attention(q, k, v, rel_table):
    B, S, H, dh = q.shape
    outs, lses = [], []
    for window, d in DILATED_PAIRS:
        win = window // (2 * d)

        def to_sub(t):
            return jnp.transpose(t.reshape(B, S // d, d, H, dh), (0, 2, 1, 3, 4)).reshape(B * d, S // d, H, dh)

        bias = _band_bias(rel_table, 0, H, win, d)
        o, lse = band_attention(to_sub(q), to_sub(k), to_sub(v), bias, win)
        outs.append(jnp.transpose(o.reshape(B, d, S // d, H, dh), (0, 2, 1, 3, 4)).reshape(B, S, H, dh))
        lses.append(jnp.transpose(lse.reshape(B, d, S // d, H), (0, 2, 1, 3)).reshape(B, S, H))
    w = jax.nn.softmax(jnp.stack(lses, axis=0), axis=0)
    return jnp.einsum('ibsh,ibshd->bshd', w.astype(q.dtype), jnp.stack(outs, axis=0))


def encoder_layer(x, rel_table, ffn1_norm, ffn1_w_gate, ffn1_w_up, ffn1_w_down,
                  attn_norm, w_in, w_out, sink,
                  ffn2_norm, ffn2_w_gate, ffn2_w_up, ffn2_w_down):
    B, S, _ = x.shape
    x = x + 0.5 * swiglu(rms_norm(x, ffn1_norm), ffn1_w_gate, ffn1_w_up, ffn1_w_down)
    h = rms_norm(x, attn_norm)
    proj = h @ w_in
    offsets = np.cumsum(IN_WIDTHS)[:-1].tolist()
    qa, ka, va, qb, kb, vb = jnp.split(proj, offsets, axis=-1)
    qa = qa.reshape(B, S, N_HEADS_A, HEAD_DIM)
    ka = ka.reshape(B, S, N_HEADS_A, HEAD_DIM)
    va = va.reshape(B, S, N_HEADS_A, HEAD_DIM)
    qb = qb.reshape(B, S, N_HEADS_B, HEAD_DIM)
    kb = kb.reshape(B, S, N_KV_B, HEAD_DIM)
    vb = vb.reshape(B, S, N_KV_B, HEAD_DIM)
    oa = dilated_attention(qa, ka, va, rel_table)
    bias_b = _band_bias(rel_table, N_HEADS_A, N_HEADS_B, WINDOW_B, 1)
    ob, _ = band_attention(qb, kb, vb, bias_b, WINDOW_B, sink)
    o = jnp.concatenate([oa.reshape(B, S, -1), ob.reshape(B, S, -1)], axis=-1)
    x = x + o @ w_out
    x = x + 0.5 * swiglu(rms_norm(x, ffn2_norm), ffn2_w_gate, ffn2_w_up, ffn2_w_down)
    return x


def trunk(x, rel_table, ffn1_norm, ffn1_w_gate, ffn1_w_up, ffn1_w_down,
          attn_norm, w_in, w_out, sink,
          ffn2_norm, ffn2_w_gate, ffn2_w_up, ffn2_w_down, final_norm):
    for l in range(DEPTH):
        x = encoder_layer(x, rel_table, ffn1_norm[l], ffn1_w_gate[l], ffn1_w_up[l], ffn1_w_down[l],
                          attn_norm[l], w_in[l], w_out[l], sink[l],
                          ffn2_norm[l], ffn2_w_gate[l], ffn2_w_up[l], ffn2_w_down[l])
    return rms_norm(x, final_norm)


def setup_inputs(seed: int = 0) -> dict:
    key = jax.random.key(seed)
    ks = jax.random.split(key, 17)
    f32 = jnp.float32
    nrm = lambda k, shape, scale: jax.random.normal(k, shape, f32) * scale
    gain = lambda k, shape: 1.0 + 0.02 * jax.random.normal(k, shape, f32)
    return {
        'x_prompt': jax.random.normal(ks[0], (BATCH, SEQ, D_MODEL), f32),
        'x_sample': jax.random.normal(ks[1], (DEC_BATCH, DEC_SEQ, D_MODEL), f32),
        'rel_table': nrm(ks[2], (N_BUCKETS, N_HEADS_A + N_HEADS_B), 0.5),
        'ffn1_norm': gain(ks[3], (DEPTH, D_MODEL)),
        'ffn1_w_gate': nrm(ks[4], (DEPTH, D_MODEL, D_FF), D_MODEL ** -0.5),
        'ffn1_w_up': nrm(ks[5], (DEPTH, D_MODEL, D_FF), D_MODEL ** -0.5),
        'ffn1_w_down': nrm(ks[6], (DEPTH, D_FF, D_MODEL), D_FF ** -0.5),
        'attn_norm': gain(ks[7], (DEPTH, D_MODEL)),
        'w_in': nrm(ks[8], (DEPTH, D_MODEL, W_IN_COLS), D_MODEL ** -0.5),
        'w_out': nrm(ks[9], (DEPTH, MIX_WIDTH, D_MODEL), MIX_WIDTH ** -0.5),
        'sink': nrm(ks[10], (DEPTH, N_HEADS_B), 0.5),
        'ffn2_norm': gain(ks[11], (DEPTH, D_MODEL)),
        'ffn2_w_gate': nrm(ks[12], (DEPTH, D_MODEL, D_FF), D_MODEL ** -0.5),
        'ffn2_w_up': nrm(ks[13], (DEPTH, D_MODEL, D_FF), D_MODEL ** -0.5),
        'ffn2_w_down': nrm(ks[14], (DEPTH, D_FF, D_MODEL), D_FF ** -0.5),
        'final_norm': gain(ks[15], (D_MODEL,)),
    }


def reference(x_prompt, x_sample, rel_table, ffn1_norm, ffn1_w_gate, ffn1_w_up, ffn1_w_down,
              attn_norm, w_in, w_out, sink,
              ffn2_norm, ffn2_w_gate, ffn2_w_up, ffn2_w_down, final_norm):
    y_prompt = trunk(x_prompt, rel_table, ffn1_norm, ffn1_w_gate, ffn1_w_up, ffn1_w_down,
                     attn_norm, w_in, w_out, sink,
                     ffn2_norm, ffn2_w_gate, ffn2_w_up, ffn2_w_down, final_norm)
    y_sample = trunk(x_sample, rel_table, ffn1_norm, ffn1_w_gate, ffn1_w_up, ffn1_w_down,
                     attn_norm, w_in, w_out, sink,
                     ffn2_norm, ffn2_w_gate, ffn2_w_up, ffn2_w_down, final_norm)
    return (y_prompt, y_sample)
```

```cpp
#include <hip/hip_runtime.h>
#include <hip/hip_cooperative_groups.h>
#include <cstdio>
#include <cstdint>
namespace cg = cooperative_groups;

#ifndef MK_PER_PHASE
#define MK_PER_PHASE 0
#endif

#define LAS __attribute__((address_space(3)))
typedef unsigned short bf16_t;
typedef short bf16x8 __attribute__((ext_vector_type(8)));
typedef float f32x4 __attribute__((ext_vector_type(4)));
typedef float f32x16 __attribute__((ext_vector_type(16)));
typedef unsigned u32x4 __attribute__((ext_vector_type(4)));
typedef unsigned u32x2 __attribute__((ext_vector_type(2)));
typedef short s16x4 __attribute__((ext_vector_type(4)));

constexpr int T = 81920, TP = 65536, DM = 1024, FF = 2816, NQKV = 2304, SEQ = 4096, NSEQ = 20;
constexpr float EPS = 1e-6f, LOG2E = 1.4426950408889634f;
constexpr float QSCALE = 0.125f * LOG2E;

constexpr size_t MiB = 1u << 20;
constexpr size_t WS_SS = 1 * MiB;
constexpr size_t WS_LSE = 4 * MiB;
constexpr size_t WS_W = 12 * MiB;
constexpr size_t W1_BYTES = (size_t)2 * FF * DM * 2, W2_BYTES = (size_t)DM * FF * 2, WIN_BYTES = (size_t)NQKV * DM * 2, WO_BYTES = (size_t)DM * DM * 2;
constexpr size_t WL_W1A = 0, WL_W2A = WL_W1A + W1_BYTES, WL_WIN = WL_W2A + W2_BYTES, WL_WO = WL_WIN + WIN_BYTES, WL_W1B = WL_WO + WO_BYTES, WL_W2B = WL_W1B + W1_BYTES, WL_BYTES = WL_W2B + W2_BYTES;
constexpr size_t WS_XB = 92 * MiB;
constexpr size_t WS_O = 252 * MiB;
constexpr size_t WS_H = 412 * MiB;
constexpr size_t WS_OP2 = 852 * MiB;
constexpr size_t WS_END = 932 * MiB;
static_assert(WS_W + 2 * WL_BYTES <= WS_XB, "weights fit");
constexpr size_t OP_BYTES = (size_t)T * 512 * 2;

namespace pg8 {
constexpr int BM = 256, BK = 64, HALF = 128, HTB = HALF * BK * 2, STAGE_BYTES = 8 * HTB, NXCD = 8, WGM = 8;
__host__ __device__ __forceinline__ int lds_byte(int r, int c) { const int st = (r >> 4) * 2 + (c >> 5), rr = r & 15, cc = c & 31, ob = rr * 64 + cc * 2; return st * 1024 + (ob ^ (((ob >> 9) & 1) << 5)); }
__host__ __device__ __forceinline__ void stage_rc(int b, int& R, int& C) { const int st = b / 1024, sb = b % 1024, swz = sb ^ (((sb >> 9) & 1) << 5); R = (st >> 1) * 16 + swz / 64; C = (st & 1) * 32 + (swz % 64) / 2; }
__host__ __device__ __forceinline__ int perm32(int rho) { const int n = rho >> 4, i = rho & 15; return 8 * (i >> 2) + 4 * n + (i & 3); }
struct Unit { int pm, pn; };
struct Gemm { const bf16_t* A; const bf16_t* Bt; int M, N, K; };
struct StaticOrder {
    int nM, nN, nwg, G, c;
    __device__ void init(int M, int N, int G_, int c_) { nM = M / BM; nN = N / BM; nwg = nM * nN; G = G_; c = c_; }
    __device__ bool next(int i, Unit& u) const {
        const long L = (long)i * G + c; if (L >= nwg) return false;
        int wgid = (int)L; { const int q = nwg / NXCD, r = nwg % NXCD, xcd = wgid % NXCD, off = wgid / NXCD; wgid = (xcd < r ? xcd * (q + 1) : r * (q + 1) + (xcd - r) * q) + off; }
        const int nig = WGM * nN, gid = wgid / nig, fm = gid * WGM, gsz = (nM - fm) < WGM ? (nM - fm) : WGM;
        u.pm = fm + ((wgid % nig) % gsz); u.pn = (wgid % nig) / gsz; return true;
    }
};
__device__ __forceinline__ unsigned cvt_pk_bf16(float lo, float hi) { unsigned r; asm volatile("v_cvt_pk_bf16_f32 %0, %1, %2" : "=v"(r) : "v"(lo), "v"(hi)); return r; }

struct EpiSwiGLU {
    static constexpr bool PERM = true;
    bf16_t* H; const float* ss;
    __device__ __forceinline__ void operator()(const f32x4 (&acc)[2][2][4][2], const Unit& u, int wr, int wc, int fr, int fq) const {
        const int row0 = u.pm * BM + wr * 64 + fr; const int col0 = u.pn * 128 + wc * 32 + 8 * fq;
#pragma unroll
        for (int ai = 0; ai < 2; ++ai)
#pragma unroll
            for (int m = 0; m < 4; ++m) {
                const int row = row0 + ai * HALF + m * 16;
                const float rs = __builtin_amdgcn_rsqf(ss[row] * (1.0f / 1024.0f) + EPS);
                float hv[8];
#pragma unroll
                for (int n = 0; n < 2; ++n)
#pragma unroll
                    for (int j = 0; j < 4; ++j) {
                        const float g = acc[ai][0][m][n][j] * rs, up = acc[ai][1][m][n][j] * rs;
                        const float e = __builtin_amdgcn_exp2f(-g * LOG2E);
                        hv[n * 4 + j] = g * __builtin_amdgcn_rcpf(1.0f + e) * up;
                    }
                u32x4 w; w.x = cvt_pk_bf16(hv[0], hv[1]); w.y = cvt_pk_bf16(hv[2], hv[3]); w.z = cvt_pk_bf16(hv[4], hv[5]); w.w = cvt_pk_bf16(hv[6], hv[7]);
                *(u32x4*)(H + (size_t)row * FF + col0) = w;
            }
    }
};
struct EpiQKV {
    static constexpr bool PERM = true;
    bf16_t* P; const float* ss;
    __device__ __forceinline__ void operator()(const f32x4 (&acc)[2][2][4][2], const Unit& u, int wr, int wc, int fr, int fq) const {
        const int row0 = u.pm * BM + wr * 64 + fr; const int col0 = u.pn * BM + wc * 32 + 8 * fq;
        const float cs = (u.pn < 2 || u.pn == 6 || u.pn == 7) ? QSCALE : 1.0f;
#pragma unroll
        for (int ai = 0; ai < 2; ++ai)
#pragma unroll
            for (int m = 0; m < 4; ++m) {
                const int row = row0 + ai * HALF + m * 16;
                const float rs = __builtin_amdgcn_rsqf(ss[row] * (1.0f / 1024.0f) + EPS) * cs;
#pragma unroll
                for (int bj = 0; bj < 2; ++bj) {
                    const f32x4 v0 = acc[ai][bj][m][0] * rs, v1 = acc[ai][bj][m][1] * rs;
                    u32x4 w; w.x = cvt_pk_bf16(v0[0], v0[1]); w.y = cvt_pk_bf16(v0[2], v0[3]); w.z = cvt_pk_bf16(v1[0], v1[1]); w.w = cvt_pk_bf16(v1[2], v1[3]);
                    *(u32x4*)(P + (size_t)row * NQKV + col0 + bj * HALF) = w;
                }
            }
    }
};
struct EpiRes {
    static constexpr bool PERM = true;
    const float* srcA; const float* srcB; float* out; bf16_t* xb; float* ssn; float alpha;
    __device__ __forceinline__ void operator()(const f32x4 (&acc)[2][2][4][2], const Unit& u, int wr, int wc, int fr, int fq) const {
        const int row0 = u.pm * BM + wr * 64 + fr; const int col0 = u.pn * BM + wc * 32 + 8 * fq;
#pragma unroll
        for (int ai = 0; ai < 2; ++ai)
#pragma unroll
            for (int m = 0; m < 4; ++m) {
                const int row = row0 + ai * HALF + m * 16;
                const float* src = (row >= TP) ? srcB + (size_t)(row - TP) * DM : srcA + (size_t)row * DM;
                const size_t off = (size_t)row * DM + col0;
                float s = 0.f;
#pragma unroll
                for (int bj = 0; bj < 2; ++bj) {
                    f32x4 a = *(const f32x4*)(src + col0 + bj * HALF), b = *(const f32x4*)(src + col0 + bj * HALF + 4);
                    a = a + acc[ai][bj][m][0] * alpha; b = b + acc[ai][bj][m][1] * alpha;
                    *(f32x4*)(out + off + bj * HALF) = a; *(f32x4*)(out + off + bj * HALF + 4) = b;
                    u32x4 w; w.x = cvt_pk_bf16(a[0], a[1]); w.y = cvt_pk_bf16(a[2], a[3]); w.z = cvt_pk_bf16(b[0], b[1]); w.w = cvt_pk_bf16(b[2], b[3]);
                    *(u32x4*)(xb + off + bj * HALF) = w;
                    s += (a[0] * a[0] + a[1] * a[1]) + (a[2] * a[2] + a[3] * a[3]) + (b[0] * b[0] + b[1] * b[1]) + (b[2] * b[2] + b[3] * b[3]);
                }
                s += __shfl_xor(s, 16); s += __shfl_xor(s, 32);
                if (fq == 0) atomicAdd(ssn + row, s);
                asm volatile("" ::: "memory");
            }
    }
};

template <class Epi, class Sched>
__device__ __forceinline__ void gemm_phase(LAS unsigned char* lds, const int tid, const Gemm g, const Sched& S, const Epi& E) {
    const int wid = __builtin_amdgcn_readfirstlane(tid >> 6), lane = tid & 63, wr = wid >> 2, wc = wid & 3, fr = lane & 15, fq = lane >> 4;
    const int K = g.K, nt = K / BK;
    unsigned voffA[2], voffB[2];
#pragma unroll
    for (int i = 0; i < 2; ++i) { int R, C; stage_rc(tid * 16 + i * 8192, R, C); const int Rb = Epi::PERM ? ((R & ~31) + perm32(R & 31)) : R;
        voffA[i] = (unsigned)(R * K + C) * 2u; voffB[i] = (unsigned)(Rb * K + C) * 2u; }
    const size_t kstep = (size_t)(BK * 2);
    const size_t hstep = (size_t)HALF * K * 2;
    const size_t tstep = 2 * hstep;
    const unsigned ldsw = (unsigned)wid * 1024u;
    const int aoff = lds_byte(wr * 64 + fr, fq * 8), boff = lds_byte(wc * 32 + fr, fq * 8);
#define PG8_SA(b, h) (((b) * 2 + (h)) * HTB)
#define PG8_SB(b, h) ((4 + (b) * 2 + (h)) * HTB)
#define PG8_STAGE(bufoff, gbase, voff) do { _Pragma("unroll") for (int _i = 0; _i < 2; ++_i) \
        __builtin_amdgcn_global_load_lds((const unsigned*)((const char*)(gbase) + (voff)[_i]), (LAS unsigned*)(lds + (bufoff) + ldsw + _i * 8192), 16, 0, 0); } while (0)
#define PG8_LDA(dst, b, h) do { _Pragma("unroll") for (int m = 0; m < 4; ++m) _Pragma("unroll") for (int k = 0; k < 2; ++k) dst[m][k] = *(const LAS bf16x8*)(lds + PG8_SA(b, h) + aoff + m * 2048 + k * 1024); } while (0)
#define PG8_LDB(dst, b, h) do { _Pragma("unroll") for (int n = 0; n < 2; ++n) _Pragma("unroll") for (int k = 0; k < 2; ++k) dst[n][k] = *(const LAS bf16x8*)(lds + PG8_SB(b, h) + boff + n * 2048 + k * 1024); } while (0)
#define PG8_MMA(ai, bj, At, Bt) do { __builtin_amdgcn_s_setprio(1); _Pragma("unroll") for (int m = 0; m < 4; ++m) _Pragma("unroll") for (int n = 0; n < 2; ++n) _Pragma("unroll") for (int k = 0; k < 2; ++k) \
        acc[ai][bj][m][n] = __builtin_amdgcn_mfma_f32_16x16x32_bf16(Bt[n][k], At[m][k], acc[ai][bj][m][n], 0, 0, 0); __builtin_amdgcn_s_setprio(0); } while (0)
#define PG8_WAIT_V(n) asm volatile("s_waitcnt vmcnt(" #n ")" ::: "memory")
#define PG8_WAIT_L(n) asm volatile("s_waitcnt lgkmcnt(" #n ")" ::: "memory")
#define PG8_BAR __builtin_amdgcn_s_barrier()
#define PG8_SCHED __builtin_amdgcn_sched_barrier(0)
    Unit cur, nxt; int ui = 0;
    if (!S.next(0, cur)) return;
    f32x4 acc[2][2][4][2];
#pragma unroll
    for (int a = 0; a < 2; ++a)
#pragma unroll
        for (int b = 0; b < 2; ++b)
#pragma unroll
            for (int m = 0; m < 4; ++m)
#pragma unroll
                for (int n = 0; n < 2; ++n) acc[a][b][m][n] = (f32x4){0.f, 0.f, 0.f, 0.f};
    bf16x8 At[4][2], B0[2][2], B1[2][2];
    const char* cA = (const char*)g.A + (size_t)cur.pm * tstep; const char* cB = (const char*)g.Bt + (size_t)cur.pn * tstep;
    PG8_STAGE(PG8_SB(0, 0), cB, voffB); PG8_STAGE(PG8_SB(0, 1), cB + hstep, voffB); PG8_STAGE(PG8_SA(0, 0), cA, voffA); PG8_STAGE(PG8_SA(0, 1), cA + hstep, voffA);
    if (wr == 1) PG8_BAR;
    PG8_WAIT_V(2); PG8_BAR;
    PG8_STAGE(PG8_SB(1, 0), cB + kstep, voffB); PG8_STAGE(PG8_SA(1, 0), cA + kstep, voffA); PG8_STAGE(PG8_SB(1, 1), cB + hstep + kstep, voffB);
    PG8_WAIT_V(6); PG8_BAR;
    for (;;) {
        const bool has_next = S.next(ui + 1, nxt);
        const char* nA = has_next ? (const char*)g.A + (size_t)nxt.pm * tstep : cA; const char* nB = has_next ? (const char*)g.Bt + (size_t)nxt.pn * tstep : cB;
        for (int t = 0; t < nt; t += 2) {
            const bool last = (t == nt - 2);
            const char* a1 = cA + (size_t)(t + 1) * kstep;
            const char* a2 = last ? nA : cA + (size_t)(t + 2) * kstep; const char* b2 = last ? nB : cB + (size_t)(t + 2) * kstep;
            const char* a3 = a2 + kstep; const char* b3 = b2 + kstep;
            PG8_LDB(B0, 0, 0); PG8_LDB(B1, 0, 1); PG8_SCHED; PG8_LDA(At, 0, 0); PG8_STAGE(PG8_SA(1, 1), a1 + hstep, voffA);
            PG8_WAIT_V(8); PG8_WAIT_L(0); PG8_BAR; PG8_MMA(0, 0, At, B0); PG8_MMA(0, 1, At, B1); PG8_BAR; PG8_SCHED;
            PG8_LDA(At, 0, 1); PG8_STAGE(PG8_SB(0, 0), b2, voffB); PG8_STAGE(PG8_SB(0, 1), b2 + hstep, voffB); PG8_STAGE(PG8_SA(0, 0), a2, voffA);
            PG8_WAIT_V(8); PG8_WAIT_L(0); PG8_BAR; PG8_MMA(1, 0, At, B0); PG8_MMA(1, 1, At, B1); PG8_BAR; PG8_SCHED;
            PG8_LDB(B0, 1, 0); PG8_LDB(B1, 1, 1); PG8_SCHED; PG8_LDA(At, 1, 0); PG8_STAGE(PG8_SA(0, 1), a2 + hstep, voffA);
            PG8_WAIT_V(8); PG8_WAIT_L(0); PG8_BAR; PG8_MMA(0, 0, At, B0); PG8_MMA(0, 1, At, B1); PG8_BAR; PG8_SCHED;
            PG8_LDA(At, 1, 1); PG8_STAGE(PG8_SB(1, 0), b3, voffB); PG8_STAGE(PG8_SB(1, 1), b3 + hstep, voffB); PG8_STAGE(PG8_SA(1, 0), a3, voffA);
            PG8_WAIT_V(8); PG8_WAIT_L(0); PG8_BAR; PG8_MMA(1, 0, At, B0); PG8_MMA(1, 1, At, B1); PG8_BAR; PG8_SCHED;
        }
        if (wr == 0) PG8_BAR;
        E(acc, cur, wr, wc, fr, fq);
        if (!has_next) break;
#pragma unroll
        for (int a = 0; a < 2; ++a)
#pragma unroll
            for (int b = 0; b < 2; ++b)
#pragma unroll
                for (int m = 0; m < 4; ++m)
#pragma unroll
                    for (int n = 0; n < 2; ++n) acc[a][b][m][n] = (f32x4){0.f, 0.f, 0.f, 0.f};
        cur = nxt; cA = nA; cB = nB; ++ui;
        if (wr == 1) PG8_BAR;
    }
    PG8_WAIT_V(0);
    PG8_BAR;
#undef PG8_SA
#undef PG8_SB
#undef PG8_STAGE
#undef PG8_LDA
#undef PG8_LDB
#undef PG8_MMA
#undef PG8_WAIT_V
#undef PG8_WAIT_L
#undef PG8_BAR
#undef PG8_SCHED
}
}

__device__ __forceinline__ float wave_sum(float v) {
#pragma unroll
    for (int o = 1; o < 64; o <<= 1) v += __shfl_xor(v, o);
    return v;
}
__device__ __forceinline__ unsigned pk2(float lo, float hi) { return pg8::cvt_pk_bf16(lo, hi); }
__device__ __forceinline__ int rel_bucket(int rel) {
    const int n = rel < 0 ? -rel : rel;
    const int v = n < 8 ? n : 8 + (n >= 15) + (n >= 27) + (n >= 50) + (n >= 91) + (n >= 166) + (n >= 305) + (n >= 559);
    return (rel > 0 ? 16 : 0) + v;
}

__device__ __forceinline__ void transpose_item(const float* W, int K, int N, const float* gain, bf16_t* WT, int mode, LAS float* scr, int item, int lane) {
    const int nblk = N / 32, kb = item / nblk, nb = item % nblk, k0 = 64 * kb, n0 = 32 * nb;
#pragma unroll 8
    for (int i = 0; i < 32; ++i) { const int kk = 2 * i + (lane >> 5); float w = W[(size_t)(k0 + kk) * N + n0 + (lane & 31)]; if (gain) w *= gain[k0 + kk]; scr[kk * 33 + (lane & 31)] = w; }
    asm volatile("s_waitcnt lgkmcnt(0)" ::: "memory");
    const int c = lane & 7;
    const int d0 = (mode == 0) ? n0 : ((n0 >> 7) * 256 + (n0 & 127) + (mode == 2 ? 128 : 0));
#pragma unroll
    for (int j = 0; j < 4; ++j) { const int n = (lane >> 3) + 8 * j; const LAS float* s = scr + (8 * c) * 33 + n;
        u32x4 o; o.x = pk2(s[0 * 33], s[1 * 33]); o.y = pk2(s[2 * 33], s[3 * 33]); o.z = pk2(s[4 * 33], s[5 * 33]); o.w = pk2(s[6 * 33], s[7 * 33]);
        *(u32x4*)(WT + (size_t)(d0 + n) * K + k0 + 8 * c) = o; }
    asm volatile("s_waitcnt lgkmcnt(0)" ::: "memory");
}

constexpr int ATT_TB_OFF = 73728, ATT_TB_N = 384;
constexpr int ATT_V_OFF = 36864;
template <bool DIL>
__device__ __forceinline__ void attn_unit(LAS unsigned char* lds, const int tid, const bf16_t* proj, const float* rel, const float* sink, bf16_t* obuf, unsigned char* ws, int u) {
    constexpr int PPK = DIL ? 32 : 8;
    constexpr int NIT = DIL ? 4 : 1;
    constexpr int KS = DIL ? 528 : 144;
    constexpr int VS = DIL ? 576 : 192;
    constexpr int WIN = DIL ? 64 : 128;
    constexpr int KFIRST = -WIN;
    constexpr int NCH = DIL ? 3 : 5;
    const int lane = tid & 63, wid = __builtin_amdgcn_readfirstlane(tid >> 6);
    const int hl = wid >> 1, qh = wid & 1, r = lane & 31, h = lane >> 5;
    int b, br = 0, sh = 0, rho = 0, q0, Ls, qcol, kcol, vcol, bhead, ocol; bf16_t* op; long ostride;
    if (DIL) {
        const int hg = u & 1, blk = (u >> 1) & 63, rest = u >> 7; br = rest % 3; b = rest / 3; sh = 2 * br;
        const int nb = 64 >> sh; rho = blk >> (6 - sh); q0 = 64 * (blk & (nb - 1)); Ls = SEQ >> sh;
        qcol = hg * 256; kcol = 512 + hg * 256; vcol = 1024 + hg * 256; bhead = hg * 4; ocol = hg * 256;
        op = (br == 2) ? (bf16_t*)(ws + WS_OP2) : (bf16_t*)(ws + WS_XB + (size_t)br * OP_BYTES); ostride = 512;
    } else {
        const int kvh = u & 1, tile = (u >> 1) & 63; b = u >> 7; q0 = 64 * tile; Ls = SEQ;
        qcol = 1536 + kvh * 256; kcol = 2048 + kvh * 64; vcol = 2176 + kvh * 64; bhead = 8 + kvh * 4; ocol = 512 + kvh * 256;
        op = obuf; ostride = 1024;
    }
    const int d = 1 << sh;
    const size_t tok0 = (size_t)b * SEQ + rho;
    const size_t tstride = (size_t)d * NQKV;
    LAS float* tb = (LAS float*)(lds + ATT_TB_OFF);
    __syncthreads();
    for (int e = tid; e < 4 * ATT_TB_N; e += 512) {
        const int hh = e / ATT_TB_N, idx = e % ATT_TB_N, delta = idx - 191;
        float v = -1e30f;
        if (delta >= -WIN && delta <= WIN) v = rel[rel_bucket(delta * d) * 16 + bhead + hh] * LOG2E;
        tb[e] = v;
    }
    bf16x8 qf[4];
    {
        const bf16_t* qrow = proj + (tok0 + (size_t)(q0 + 32 * qh + r) * d) * NQKV + qcol + hl * 64 + 8 * h;
#pragma unroll
        for (int s = 0; s < 4; ++s) qf[s] = *(const bf16x8*)(qrow + 16 * s);
    }
    int c_lo = 0, c_hi = NCH - 1;
    while (q0 + KFIRST + 64 * c_lo < 0) ++c_lo;
    while (q0 + KFIRST + 64 * c_hi >= Ls) --c_hi;
    u32x4 kreg[NIT], vreg[NIT];
    const bf16_t* kbase = proj + tok0 * NQKV;
#define ATT_PREFETCH(c) do { const int ks0 = q0 + KFIRST + 64 * (c); _Pragma("unroll") for (int i = 0; i < NIT; ++i) { const int p = tid + 512 * i, key = p / PPK, hc = p % PPK; \
        const bf16_t* src = kbase + (size_t)(ks0 + key) * tstride + hc * 8; kreg[i] = *(const u32x4*)(src + kcol); vreg[i] = *(const u32x4*)(src + vcol); } } while (0)
    ATT_PREFETCH(c_lo);
    float m_run, l_run;
    if (DIL) { m_run = -1e30f; l_run = 0.f; } else { m_run = sink[(bhead - 8) + hl] * LOG2E; l_run = (h == 0) ? 1.0f : 0.0f; }
    f32x16 o0, o1;
#pragma unroll
    for (int i = 0; i < 16; ++i) { o0[i] = 0.f; o1[i] = 0.f; }
    const int hlk = DIL ? hl : 0;
    const LAS unsigned char* kread = lds + r * KS + hlk * 128 + 16 * h;
    const LAS unsigned char* vread = lds + ATT_V_OFF + (4 * h + ((lane & 15) >> 2)) * VS + (hlk * 64 + 16 * ((lane >> 4) & 1) + 4 * (lane & 3)) * 2;
    for (int c = c_lo; c <= c_hi; ++c) {
        __syncthreads();
#pragma unroll
        for (int i = 0; i < NIT; ++i) { const int p = tid + 512 * i, key = p / PPK, hc = p % PPK;
            *(LAS u32x4*)(lds + key * KS + hc * 16) = kreg[i]; *(LAS u32x4*)(lds + ATT_V_OFF + key * VS + hc * 16) = vreg[i]; }
        __syncthreads();
        if (c < c_hi) ATT_PREFETCH(c + 1);
        f32x16 x0, x1;
#pragma unroll
        for (int i = 0; i < 16; ++i) { x0[i] = 0.f; x1[i] = 0.f; }
#pragma unroll
        for (int s = 0; s < 4; ++s) {
            const bf16x8 a0 = *(const LAS bf16x8*)(kread + s * 32), a1 = *(const LAS bf16x8*)(kread + 32 * KS + s * 32);
            x0 = __builtin_amdgcn_mfma_f32_32x32x16_bf16(a0, qf[s], x0, 0, 0, 0);
            x1 = __builtin_amdgcn_mfma_f32_32x32x16_bf16(a1, qf[s], x1, 0, 0, 0);
        }
        const LAS float* tbp = tb + hl * ATT_TB_N + (KFIRST + 64 * c + 191 + 4 * h - 32 * qh - r);
        float mx = -1e30f;
#pragma unroll
        for (int i = 0; i < 16; ++i) { const int ko = (i & 3) + 8 * (i >> 2); x0[i] += tbp[ko]; x1[i] += tbp[32 + ko]; mx = fmaxf(mx, fmaxf(x0[i], x1[i])); }
        mx = fmaxf(mx, __shfl_xor(mx, 32));
        const float m_new = fmaxf(m_run, mx), alpha = __builtin_amdgcn_exp2f(m_run - m_new); m_run = m_new;
        float rsum = 0.f;
#pragma unroll
        for (int i = 0; i < 16; ++i) { x0[i] = __builtin_amdgcn_exp2f(x0[i] - m_new); x1[i] = __builtin_amdgcn_exp2f(x1[i] - m_new); rsum += x0[i] + x1[i]; }
        l_run = l_run * alpha + rsum;
#pragma unroll
        for (int i = 0; i < 16; ++i) { o0[i] *= alpha; o1[i] *= alpha; }
#pragma unroll
        for (int kb = 0; kb < 2; ++kb)
#pragma unroll
            for (int s = 0; s < 2; ++s) {
                u32x4 pw;
                if (kb == 0) { pw.x = pk2(x0[8 * s + 0], x0[8 * s + 1]); pw.y = pk2(x0[8 * s + 2], x0[8 * s + 3]); pw.z = pk2(x0[8 * s + 4], x0[8 * s + 5]); pw.w = pk2(x0[8 * s + 6], x0[8 * s + 7]); }
                else         { pw.x = pk2(x1[8 * s + 0], x1[8 * s + 1]); pw.y = pk2(x1[8 * s + 2], x1[8 * s + 3]); pw.z = pk2(x1[8 * s + 4], x1[8 * s + 5]); pw.w = pk2(x1[8 * s + 6], x1[8 * s + 7]); }
                const bf16x8 pb = __builtin_bit_cast(bf16x8, pw);
                const LAS unsigned char* vp = vread + (32 * kb + 16 * s) * VS;
                const s16x4 lo0 = __builtin_bit_cast(s16x4, __builtin_amdgcn_ds_read_tr16_b64_v4i16((LAS s16x4*)(vp)));
                const s16x4 hi0 = __builtin_bit_cast(s16x4, __builtin_amdgcn_ds_read_tr16_b64_v4i16((LAS s16x4*)(vp + 8 * VS)));
                const s16x4 lo1 = __builtin_bit_cast(s16x4, __builtin_amdgcn_ds_read_tr16_b64_v4i16((LAS s16x4*)(vp + 64)));
                const s16x4 hi1 = __builtin_bit_cast(s16x4, __builtin_amdgcn_ds_read_tr16_b64_v4i16((LAS s16x4*)(vp + 64 + 8 * VS)));
                const bf16x8 va0 = (bf16x8){lo0[0], lo0[1], lo0[2], lo0[3], hi0[0], hi0[1], hi0[2], hi0[3]};
                const bf16x8 va1 = (bf16x8){lo1[0], lo1[1], lo1[2], lo1[3], hi1[0], hi1[1], hi1[2], hi1[3]};
                o0 = __builtin_amdgcn_mfma_f32_32x32x16_bf16(va0, pb, o0, 0, 0, 0);
                o1 = __builtin_amdgcn_mfma_f32_32x32x16_bf16(va1, pb, o1, 0, 0, 0);
            }
    }
#undef ATT_PREFETCH
    const float l_tot = l_run + __shfl_xor(l_run, 32);
    const float inv = 1.0f / l_tot;
    const size_t tok = tok0 + (size_t)(q0 + 32 * qh + r) * d;
    bf16_t* orow = op + tok * ostride + ocol + hl * 64 + 4 * h;
#pragma unroll
    for (int g4 = 0; g4 < 4; ++g4) {
        u32x2 w0, w1;
        w0.x = pk2(o0[4 * g4 + 0] * inv, o0[4 * g4 + 1] * inv); w0.y = pk2(o0[4 * g4 + 2] * inv, o0[4 * g4 + 3] * inv);
        w1.x = pk2(o1[4 * g4 + 0] * inv, o1[4 * g4 + 1] * inv); w1.y = pk2(o1[4 * g4 + 2] * inv, o1[4 * g4 + 3] * inv);
        *(u32x2*)(orow + 8 * g4) = w0; *(u32x2*)(orow + 32 + 8 * g4) = w1;
    }
    if (DIL && h == 0) { float* lse = (float*)(ws + WS_LSE); lse[((size_t)br * T + tok) * 8 + bhead + hl] = m_run + __builtin_amdgcn_logf(l_tot); }
}

struct Args { const float* in[16]; float* out; unsigned char* ws; int ph_lo, ph_hi, coop, pad; };
constexpr int LDS_BYTES = 147456;
constexpr int N_PHASES = 18;

__global__ void __launch_bounds__(512, 2) fwd_mega(Args args) {
    extern __shared__ __attribute__((aligned(16))) unsigned char lds_raw[];
    LAS unsigned char* lds = (LAS unsigned char*)lds_raw;
    cg::grid_group grid = cg::this_grid();
    const int ph_hi = args.ph_hi, coop = args.coop;
    for (int ph = args.ph_lo; ph < ph_hi; ++ph) {
        int tid = threadIdx.x; asm volatile("" : "+v"(tid));
        int bidx = blockIdx.x; asm volatile("" : "+s"(bidx));
        const __attribute__((address_space(4))) Args* ap = (const __attribute__((address_space(4))) Args*)__builtin_amdgcn_kernarg_segment_ptr(); asm volatile("" : "+s"(ap));
        const int lane = tid & 63, wave = __builtin_amdgcn_readfirstlane(tid >> 6);
        const int G = gridDim.x, gw = bidx * 8 + wave, NGW = G * 8;
        unsigned char* ws = ap->ws;
        float* ssb = (float*)(ws + WS_SS);
        bf16_t* XB = (bf16_t*)(ws + WS_XB); bf16_t* OB = (bf16_t*)(ws + WS_O); bf16_t* HB = (bf16_t*)(ws + WS_H);
        float* out = ap->out;
        if (ph == 0) {
            LAS float* scr = (LAS float*)(lds + wave * 16384);
            constexpr int I_GU = (DM / 64) * (FF / 32), I_DN = (FF / 64) * (DM / 32), I_IN = (DM / 64) * (NQKV / 32), I_WO = (DM / 64) * (DM / 32);
            constexpr int I_LAYER = 4 * I_GU + 2 * I_DN + I_IN + I_WO;
            for (int it = gw; it < 2 * I_LAYER; it += NGW) {
                const int l = it / I_LAYER; int rr = it % I_LAYER;
                unsigned char* wl = ws + WS_W + (size_t)l * WL_BYTES;
                if (rr < I_GU) { transpose_item(ap->in[4] + (size_t)l * DM * FF, DM, FF, ap->in[3] + l * DM, (bf16_t*)(wl + WL_W1A), 1, scr, rr, lane); continue; } rr -= I_GU;
                if (rr < I_GU) { transpose_item(ap->in[5] + (size_t)l * DM * FF, DM, FF, ap->in[3] + l * DM, (bf16_t*)(wl + WL_W1A), 2, scr, rr, lane); continue; } rr -= I_GU;
                if (rr < I_DN) { transpose_item(ap->in[6] + (size_t)l * FF * DM, FF, DM, nullptr, (bf16_t*)(wl + WL_W2A), 0, scr, rr, lane); continue; } rr -= I_DN;
                if (rr < I_GU) { transpose_item(ap->in[12] + (size_t)l * DM * FF, DM, FF, ap->in[11] + l * DM, (bf16_t*)(wl + WL_W1B), 1, scr, rr, lane); continue; } rr -= I_GU;
                if (rr < I_GU) { transpose_item(ap->in[13] + (size_t)l * DM * FF, DM, FF, ap->in[11] + l * DM, (bf16_t*)(wl + WL_W1B), 2, scr, rr, lane); continue; } rr -= I_GU;
                if (rr < I_DN) { transpose_item(ap->in[14] + (size_t)l * FF * DM, FF, DM, nullptr, (bf16_t*)(wl + WL_W2B), 0, scr, rr, lane); continue; } rr -= I_DN;
                if (rr < I_IN) { transpose_item(ap->in[8] + (size_t)l * DM * NQKV, DM, NQKV, ap->in[7] + l * DM, (bf16_t*)(wl + WL_WIN), 0, scr, rr, lane); continue; } rr -= I_IN;
                transpose_item(ap->in[9] + (size_t)l * DM * DM, DM, DM, nullptr, (bf16_t*)(wl + WL_WO), 0, scr, rr, lane);
            }
            for (int row = gw; row < T; row += NGW) {
                const float* src = (row >= TP) ? ap->in[1] + (size_t)(row - TP) * DM : ap->in[0] + (size_t)row * DM;
                const f32x4* xr = (const f32x4*)src + lane; f32x4 v[4]; float s = 0.f;
#pragma unroll
                for (int j = 0; j < 4; ++j) { v[j] = xr[64 * j]; s += (v[j][0] * v[j][0] + v[j][1] * v[j][1]) + (v[j][2] * v[j][2] + v[j][3] * v[j][3]); }
                s = wave_sum(s);
                u32x2* o8 = (u32x2*)(XB + (size_t)row * DM) + lane;
#pragma unroll
                for (int j = 0; j < 4; ++j) { u32x2 w; w.x = pk2(v[j][0], v[j][1]); w.y = pk2(v[j][2], v[j][3]); o8[64 * j] = w; }
                if (lane == 0) ssb[row] = s;
            }
            for (int i = bidx * 512 + tid; i < 6 * T; i += G * 512) ssb[T + i] = 0.f;
        } else if (ph == N_PHASES - 1) {
            const float* ss = ssb + 6 * (size_t)T; const float* gf = ap->in[15];
            f32x4 gv[4];
#pragma unroll
            for (int j = 0; j < 4; ++j) gv[j] = ((const f32x4*)gf)[lane + 64 * j];
            for (int row = gw; row < T; row += NGW) {
                const float rs = __builtin_amdgcn_rsqf(ss[row] * (1.0f / 1024.0f) + EPS);
                f32x4* xr = (f32x4*)(out + (size_t)row * DM) + lane;
#pragma unroll
                for (int j = 0; j < 4; ++j) { f32x4 v = xr[64 * j]; v = v * rs * gv[j]; xr[64 * j] = v; }
            }
        } else {
            const int l = (ph - 1) >> 3, k = (ph - 1) & 7;
            unsigned char* wl = ws + WS_W + (size_t)l * WL_BYTES;
            if (k == 0 || k == 6) {
                const float* ss = ssb + (size_t)(3 * l + (k == 0 ? 0 : 2)) * T;
                pg8::Gemm g{XB, (const bf16_t*)(wl + (k == 0 ? WL_W1A : WL_W1B)), T, 2 * FF, DM};
                pg8::StaticOrder S; S.init(T, 2 * FF, G, bidx);
                pg8::EpiSwiGLU E{HB, ss};
                pg8::gemm_phase<pg8::EpiSwiGLU, pg8::StaticOrder>(lds, tid, g, S, E);
            } else if (k == 1 || k == 7 || k == 5) {
                const bool first = (l == 0 && k == 1);
                const float* sA = first ? ap->in[0] : out; const float* sB = first ? ap->in[1] : out + (size_t)TP * DM;
                float* ssn = ssb + (size_t)(3 * l + (k == 1 ? 1 : (k == 5 ? 2 : 3))) * T;
                if (k == 5) {
                    pg8::Gemm g{OB, (const bf16_t*)(wl + WL_WO), T, DM, DM};
                    pg8::StaticOrder S; S.init(T, DM, G, bidx);
                    pg8::EpiRes E{sA, sB, out, XB, ssn, 1.0f};
                    pg8::gemm_phase<pg8::EpiRes, pg8::StaticOrder>(lds, tid, g, S, E);
                } else {
                    pg8::Gemm g{HB, (const bf16_t*)(wl + (k == 1 ? WL_W2A : WL_W2B)), T, DM, FF};
                    pg8::StaticOrder S; S.init(T, DM, G, bidx);
                    pg8::EpiRes E{sA, sB, out, XB, ssn, 0.5f};
                    pg8::gemm_phase<pg8::EpiRes, pg8::StaticOrder>(lds, tid, g, S, E);
                }
            } else if (k == 2) {
                const float* ss = ssb + (size_t)(3 * l + 1) * T;
                pg8::Gemm g{XB, (const bf16_t*)(wl + WL_WIN), T, NQKV, DM};
                pg8::StaticOrder S; S.init(T, NQKV, G, bidx);
                pg8::EpiQKV E{HB, ss};
                pg8::gemm_phase<pg8::EpiQKV, pg8::StaticOrder>(lds, tid, g, S, E);
            } else if (k == 3) {
                const float* rel = ap->in[2]; const float* sink = ap->in[10] + l * 8;
                for (int i = bidx; i < 2560 + 7680; i += G) {
                    if (i < 2560) attn_unit<false>(lds, tid, HB, rel, sink, OB, ws, i);
                    else attn_unit<true>(lds, tid, HB, rel, sink, OB, ws, i - 2560);
                }
                __syncthreads();
            } else {
                const float* lse = (const float*)(ws + WS_LSE);
                const bf16_t* p0 = (const bf16_t*)(ws + WS_XB); const bf16_t* p1 = (const bf16_t*)(ws + WS_XB + OP_BYTES); const bf16_t* p2 = (const bf16_t*)(ws + WS_OP2);
                for (size_t idx = (size_t)bidx * 512 + tid; idx < (size_t)T * 64; idx += (size_t)G * 512) {
                    const size_t tok = idx >> 6; const int hd = (int)(idx >> 3) & 7, c8 = (int)idx & 7;
                    const float l0 = lse[tok * 8 + hd], l1 = lse[((size_t)T + tok) * 8 + hd], l2 = lse[((size_t)2 * T + tok) * 8 + hd];
                    const float mx = fmaxf(l0, fmaxf(l1, l2));
                    float w0 = __builtin_amdgcn_exp2f(l0 - mx), w1 = __builtin_amdgcn_exp2f(l1 - mx), w2 = __builtin_amdgcn_exp2f(l2 - mx);
                    const float inv = 1.0f / (w0 + w1 + w2); w0 *= inv; w1 *= inv; w2 *= inv;
                    const size_t off = tok * 512 + hd * 64 + c8 * 8;
                    const u32x4 a = *(const u32x4*)(p0 + off), bq = *(const u32x4*)(p1 + off), cq = *(const u32x4*)(p2 + off);
                    u32x4 o;
#pragma unroll
                    for (int j = 0; j < 4; ++j) {
                        const float a_lo = __uint_as_float(a[j] << 16), a_hi = __uint_as_float(a[j] & 0xffff0000u);
                        const float b_lo = __uint_as_float(bq[j] << 16), b_hi = __uint_as_float(bq[j] & 0xffff0000u);
                        const float c_lo = __uint_as_float(cq[j] << 16), c_hi = __uint_as_float(cq[j] & 0xffff0000u);
                        o[j] = pk2(w0 * a_lo + w1 * b_lo + w2 * c_lo, w0 * a_hi + w1 * b_hi + w2 * c_hi);
                    }
                    *(u32x4*)(OB + tok * 1024 + hd * 64 + c8 * 8) = o;
                }
            }
        }
        if (ph + 1 < ph_hi) { if (coop) grid.sync(); }
    }
}

extern "C" void kernel_launch(void* const* d_in, const int* in_sizes, int n_in, void* d_out, int out_size, void* d_ws, size_t ws_size, hipStream_t stream) {
    static int grid = 0;
    if (grid == 0) {
        if (n_in != 16 || out_size != T * DM || ws_size < WS_END) { fprintf(stderr, "kernel_launch: unexpected shapes (n_in %d out %d ws %zu)\n", n_in, out_size, ws_size); grid = -1; return; }
        int dev = 0, cus = 0, per_cu = 0;
        hipGetDevice(&dev); hipDeviceGetAttribute(&cus, hipDeviceAttributeMultiprocessorCount, dev);
        if (hipFuncSetAttribute((const void*)fwd_mega, hipFuncAttributeMaxDynamicSharedMemorySize, LDS_BYTES) != hipSuccess) { fprintf(stderr, "kernel_launch: hipFuncSetAttribute failed\n"); grid = -1; return; }
        if (hipOccupancyMaxActiveBlocksPerMultiprocessor(&per_cu, (const void*)fwd_mega, 512, LDS_BYTES) != hipSuccess || per_cu < 1) per_cu = 1;
        (void)hipGetLastError();
        grid = cus * per_cu;
    }
    if (grid < 0) return;
    Args a{};
    for (int i = 0; i < 16; ++i) a.in[i] = (const float*)d_in[i];
    a.out = (float*)d_out; a.ws = (unsigned char*)d_ws;
#if MK_PER_PHASE
    for (int ph = 0; ph < N_PHASES; ++ph) {
        a.ph_lo = ph; a.ph_hi = ph + 1; a.coop = 0;
        hipLaunchKernelGGL(fwd_mega, dim3(grid), dim3(512), LDS_BYTES, stream, a);
    }
#else
    a.ph_lo = 0; a.ph_hi = N_PHASES; a.coop = 1;
    void* kargs[] = {&a};
    hipError_t e = hipLaunchCooperativeKernel((const void*)fwd_mega, dim3(grid), dim3(512), kargs, LDS_BYTES, stream);
    if (e != hipSuccess) fprintf(stderr, "cooperative launch failed: %s (grid %d)\n", hipGetErrorString(e), grid);
#endif
}
```

```cpp
#include <hip/hip_runtime.h>
#include <hip/hip_cooperative_groups.h>
#include <cstdio>
#include <cstdint>
namespace cg = cooperative_groups;

#ifndef MK_PER_PHASE
#define MK_PER_PHASE 0
#endif

#define LAS __attribute__((address_space(3)))
typedef unsigned short bf16_t;
typedef short bf16x8 __attribute__((ext_vector_type(8)));
typedef float f32x4 __attribute__((ext_vector_type(4)));
typedef float f32x16 __attribute__((ext_vector_type(16)));
typedef unsigned u32x4 __attribute__((ext_vector_type(4)));
typedef unsigned u32x2 __attribute__((ext_vector_type(2)));
typedef short s16x4 __attribute__((ext_vector_type(4)));

constexpr int T = 81920, TP = 65536, DM = 1024, FF = 2816, NQKV = 2304, SEQ = 4096, NSEQ = 20;
constexpr float EPS = 1e-6f, LOG2E = 1.4426950408889634f;
constexpr float QSCALE = 0.125f * LOG2E;

constexpr size_t MiB = 1u << 20;
constexpr size_t WS_SS = 1 * MiB;
constexpr size_t WS_LSE = 4 * MiB;
constexpr size_t WS_W = 12 * MiB;
constexpr size_t W1_BYTES = (size_t)2 * FF * DM * 2, W2_BYTES = (size_t)DM * FF * 2, WIN_BYTES = (size_t)NQKV * DM * 2, WO_BYTES = (size_t)DM * DM * 2;
constexpr size_t WL_W1A = 0, WL_W2A = WL_W1A + W1_BYTES, WL_WIN = WL_W2A + W2_BYTES, WL_WO = WL_WIN + WIN_BYTES, WL_W1B = WL_WO + WO_BYTES, WL_W2B = WL_W1B + W1_BYTES, WL_BYTES = WL_W2B + W2_BYTES;
constexpr size_t WS_XB = 92 * MiB;
constexpr size_t WS_O = 252 * MiB;
constexpr size_t WS_H = 412 * MiB;
constexpr size_t WS_OP2 = 852 * MiB;
constexpr size_t WS_BAR = 932 * MiB;
constexpr size_t WS_END = 933 * MiB;
constexpr int LDS_BARST_OFF = 131072 + 512;
static_assert(WS_W + 2 * WL_BYTES <= WS_XB, "weights fit");
constexpr size_t OP_BYTES = (size_t)T * 512 * 2;

namespace pg8 {
constexpr int BM = 256, BK = 64, HALF = 128, HTB = HALF * BK * 2, STAGE_BYTES = 8 * HTB, NXCD = 8, WGM = 8;
__host__ __device__ __forceinline__ int lds_byte(int r, int c) { const int st = (r >> 4) * 2 + (c >> 5), rr = r & 15, cc = c & 31, ob = rr * 64 + cc * 2; return st * 1024 + (ob ^ (((ob >> 9) & 1) << 5)); }
__host__ __device__ __forceinline__ void stage_rc(int b, int& R, int& C) { const int st = b / 1024, sb = b % 1024, swz = sb ^ (((sb >> 9) & 1) << 5); R = (st >> 1) * 16 + swz / 64; C = (st & 1) * 32 + (swz % 64) / 2; }
__host__ __device__ __forceinline__ int perm32(int rho) { const int n = rho >> 4, i = rho & 15; return 8 * (i >> 2) + 4 * n + (i & 3); }
struct Unit { int pm, pn; };
struct Gemm { const bf16_t* A; const bf16_t* Bt; int M, N, K; };
struct StaticOrder {
    int nM, nN, nwg, G, c;
    __device__ void init(int M, int N, int G_, int c_) { nM = M / BM; nN = N / BM; nwg = nM * nN; G = G_; c = c_; }
    __device__ bool next(int i, Unit& u) const {
        const long L = (long)i * G + c; if (L >= nwg) return false;
        int wgid = (int)L; { const int q = nwg / NXCD, r = nwg % NXCD, xcd = wgid % NXCD, off = wgid / NXCD; wgid = (xcd < r ? xcd * (q + 1) : r * (q + 1) + (xcd - r) * q) + off; }
        const int nig = WGM * nN, gid = wgid / nig, fm = gid * WGM, gsz = (nM - fm) < WGM ? (nM - fm) : WGM;
        u.pm = fm + ((wgid % nig) % gsz); u.pn = (wgid % nig) / gsz; return true;
    }
};
__device__ __forceinline__ unsigned cvt_pk_bf16(float lo, float hi) { unsigned r; asm volatile("v_cvt_pk_bf16_f32 %0, %1, %2" : "=v"(r) : "v"(lo), "v"(hi)); return r; }

struct EpiSwiGLU {
    static constexpr bool PERM = true;
    bf16_t* H; const float* ss;
    __device__ __forceinline__ void operator()(const f32x4 (&acc)[2][2][4][2], const Unit& u, int wr, int wc, int fr, int fq) const {
        const int row0 = u.pm * BM + wr * 64 + fr; const int col0 = u.pn * 128 + wc * 32 + 8 * fq;
#pragma unroll
        for (int ai = 0; ai < 2; ++ai)
#pragma unroll
            for (int m = 0; m < 4; ++m) {
                const int row = row0 + ai * HALF + m * 16;
                const float rs = __builtin_amdgcn_rsqf(ss[row] * (1.0f / 1024.0f) + EPS);
                float hv[8];
#pragma unroll
                for (int n = 0; n < 2; ++n)
#pragma unroll
                    for (int j = 0; j < 4; ++j) {
                        const float g = acc[ai][0][m][n][j] * rs, up = acc[ai][1][m][n][j] * rs;
                        const float e = __builtin_amdgcn_exp2f(-g * LOG2E);
                        hv[n * 4 + j] = g * __builtin_amdgcn_rcpf(1.0f + e) * up;
                    }
                u32x4 w; w.x = cvt_pk_bf16(hv[0], hv[1]); w.y = cvt_pk_bf16(hv[2], hv[3]); w.z = cvt_pk_bf16(hv[4], hv[5]); w.w = cvt_pk_bf16(hv[6], hv[7]);
                *(u32x4*)(H + (size_t)row * FF + col0) = w;
            }
    }
};
struct EpiQKV {
    static constexpr bool PERM = true;
    bf16_t* P; const float* ss;
    __device__ __forceinline__ void operator()(const f32x4 (&acc)[2][2][4][2], const Unit& u, int wr, int wc, int fr, int fq) const {
        const int row0 = u.pm * BM + wr * 64 + fr; const int col0 = u.pn * BM + wc * 32 + 8 * fq;
        const float cs = (u.pn < 2 || u.pn == 6 || u.pn == 7) ? QSCALE : 1.0f;
#pragma unroll
        for (int ai = 0; ai < 2; ++ai)
#pragma unroll
            for (int m = 0; m < 4; ++m) {
                const int row = row0 + ai * HALF + m * 16;
                const float rs = __builtin_amdgcn_rsqf(ss[row] * (1.0f / 1024.0f) + EPS) * cs;
#pragma unroll
                for (int bj = 0; bj < 2; ++bj) {
                    const f32x4 v0 = acc[ai][bj][m][0] * rs, v1 = acc[ai][bj][m][1] * rs;
                    u32x4 w; w.x = cvt_pk_bf16(v0[0], v0[1]); w.y = cvt_pk_bf16(v0[2], v0[3]); w.z = cvt_pk_bf16(v1[0], v1[1]); w.w = cvt_pk_bf16(v1[2], v1[3]);
                    *(u32x4*)(P + (size_t)row * NQKV + col0 + bj * HALF) = w;
                }
            }
    }
};
struct EpiRes {
    static constexpr bool PERM = true;
    const float* srcA; const float* srcB; float* out; bf16_t* xb; float* ssn; float alpha;
    __device__ __forceinline__ void operator()(const f32x4 (&acc)[2][2][4][2], const Unit& u, int wr, int wc, int fr, int fq) const {
        const int row0 = u.pm * BM + wr * 64 + fr; const int col0 = u.pn * BM + wc * 32 + 8 * fq;
#pragma unroll
        for (int ai = 0; ai < 2; ++ai)
#pragma unroll
            for (int m = 0; m < 4; ++m) {
                const int row = row0 + ai * HALF + m * 16;
                const float* src = (row >= TP) ? srcB + (size_t)(row - TP) * DM : srcA + (size_t)row * DM;
                const size_t off = (size_t)row * DM + col0;
                float s = 0.f;
#pragma unroll
                for (int bj = 0; bj < 2; ++bj) {
                    f32x4 a = *(const f32x4*)(src + col0 + bj * HALF), b = *(const f32x4*)(src + col0 + bj * HALF + 4);
                    a = a + acc[ai][bj][m][0] * alpha; b = b + acc[ai][bj][m][1] * alpha;
                    *(f32x4*)(out + off + bj * HALF) = a; *(f32x4*)(out + off + bj * HALF + 4) = b;
                    u32x4 w; w.x = cvt_pk_bf16(a[0], a[1]); w.y = cvt_pk_bf16(a[2], a[3]); w.z = cvt_pk_bf16(b[0], b[1]); w.w = cvt_pk_bf16(b[2], b[3]);
                    *(u32x4*)(xb + off + bj * HALF) = w;
                    s += (a[0] * a[0] + a[1] * a[1]) + (a[2] * a[2] + a[3] * a[3]) + (b[0] * b[0] + b[1] * b[1]) + (b[2] * b[2] + b[3] * b[3]);
                }
                s += __shfl_xor(s, 16); s += __shfl_xor(s, 32);
                if (fq == 0) atomicAdd(ssn + row, s);
                asm volatile("" ::: "memory");
            }
    }
};

template <class Epi, class Sched>
__device__ __forceinline__ void gemm_phase(LAS unsigned char* lds, const int tid, const Gemm g, const Sched& S, const Epi& E) {
    const int wid = __builtin_amdgcn_readfirstlane(tid >> 6), lane = tid & 63, wr = wid >> 2, wc = wid & 3, fr = lane & 15, fq = lane >> 4;
    const int K = g.K, nt = K / BK;
    unsigned voffA[2], voffB[2];
#pragma unroll
    for (int i = 0; i < 2; ++i) { int R, C; stage_rc(tid * 16 + i * 8192, R, C); const int Rb = Epi::PERM ? ((R & ~31) + perm32(R & 31)) : R;
        voffA[i] = (unsigned)(R * K + C) * 2u; voffB[i] = (unsigned)(Rb * K + C) * 2u; }
    const size_t kstep = (size_t)(BK * 2);
    const size_t hstep = (size_t)HALF * K * 2;
    const size_t tstep = 2 * hstep;
    const unsigned ldsw = (unsigned)wid * 1024u;
    const int aoff = lds_byte(wr * 64 + fr, fq * 8), boff = lds_byte(wc * 32 + fr, fq * 8);
#define PG8_SA(b, h) (((b) * 2 + (h)) * HTB)
#define PG8_SB(b, h) ((4 + (b) * 2 + (h)) * HTB)
#define PG8_STAGE(bufoff, gbase, voff) do { _Pragma("unroll") for (int _i = 0; _i < 2; ++_i) \
        __builtin_amdgcn_global_load_lds((const unsigned*)((const char*)(gbase) + (voff)[_i]), (LAS unsigned*)(lds + (bufoff) + ldsw + _i * 8192), 16, 0, 0); } while (0)
#define PG8_LDA(dst, b, h) do { _Pragma("unroll") for (int m = 0; m < 4; ++m) _Pragma("unroll") for (int k = 0; k < 2; ++k) dst[m][k] = *(const LAS bf16x8*)(lds + PG8_SA(b, h) + aoff + m * 2048 + k * 1024); } while (0)
#define PG8_LDB(dst, b, h) do { _Pragma("unroll") for (int n = 0; n < 2; ++n) _Pragma("unroll") for (int k = 0; k < 2; ++k) dst[n][k] = *(const LAS bf16x8*)(lds + PG8_SB(b, h) + boff + n * 2048 + k * 1024); } while (0)
#define PG8_MMA(ai, bj, At, Bt) do { __builtin_amdgcn_s_setprio(1); _Pragma("unroll") for (int m = 0; m < 4; ++m) _Pragma("unroll") for (int n = 0; n < 2; ++n) _Pragma("unroll") for (int k = 0; k < 2; ++k) \
        acc[ai][bj][m][n] = __builtin_amdgcn_mfma_f32_16x16x32_bf16(Bt[n][k], At[m][k], acc[ai][bj][m][n], 0, 0, 0); __builtin_amdgcn_s_setprio(0); } while (0)
#define PG8_WAIT_V(n) asm volatile("s_waitcnt vmcnt(" #n ")" ::: "memory")
#define PG8_WAIT_L(n) asm volatile("s_waitcnt lgkmcnt(" #n ")" ::: "memory")
#define PG8_BAR __builtin_amdgcn_s_barrier()
#define PG8_SCHED __builtin_amdgcn_sched_barrier(0)
    Unit cur, nxt; int ui = 0;
    if (!S.next(0, cur)) return;
    f32x4 acc[2][2][4][2];
#pragma unroll
    for (int a = 0; a < 2; ++a)
#pragma unroll
        for (int b = 0; b < 2; ++b)
#pragma unroll
            for (int m = 0; m < 4; ++m)
#pragma unroll
                for (int n = 0; n < 2; ++n) acc[a][b][m][n] = (f32x4){0.f, 0.f, 0.f, 0.f};
    bf16x8 At[4][2], B0[2][2], B1[2][2];
    const char* cA = (const char*)g.A + (size_t)cur.pm * tstep; const char* cB = (const char*)g.Bt + (size_t)cur.pn * tstep;
    PG8_STAGE(PG8_SB(0, 0), cB, voffB); PG8_STAGE(PG8_SB(0, 1), cB + hstep, voffB); PG8_STAGE(PG8_SA(0, 0), cA, voffA); PG8_STAGE(PG8_SA(0, 1), cA + hstep, voffA);
    if (wr == 1) PG8_BAR;
    PG8_WAIT_V(2); PG8_BAR;
    PG8_STAGE(PG8_SB(1, 0), cB + kstep, voffB); PG8_STAGE(PG8_SA(1, 0), cA + kstep, voffA); PG8_STAGE(PG8_SB(1, 1), cB + hstep + kstep, voffB);
    PG8_WAIT_V(6); PG8_BAR;
    for (;;) {
        const bool has_next = S.next(ui + 1, nxt);
        const char* nA = has_next ? (const char*)g.A + (size_t)nxt.pm * tstep : cA; const char* nB = has_next ? (const char*)g.Bt + (size_t)nxt.pn * tstep : cB;
        for (int t = 0; t < nt; t += 2) {
            const bool last = (t == nt - 2);
            const char* a1 = cA + (size_t)(t + 1) * kstep;
            const char* a2 = last ? nA : cA + (size_t)(t + 2) * kstep; const char* b2 = last ? nB : cB + (size_t)(t + 2) * kstep;
            const char* a3 = a2 + kstep; const char* b3 = b2 + kstep;
            PG8_LDB(B0, 0, 0); PG8_LDB(B1, 0, 1); PG8_SCHED; PG8_LDA(At, 0, 0); PG8_STAGE(PG8_SA(1, 1), a1 + hstep, voffA);
            PG8_WAIT_V(8); PG8_WAIT_L(0); PG8_BAR; PG8_MMA(0, 0, At, B0); PG8_MMA(0, 1, At, B1); PG8_BAR; PG8_SCHED;
            PG8_LDA(At, 0, 1); PG8_STAGE(PG8_SB(0, 0), b2, voffB); PG8_STAGE(PG8_SB(0, 1), b2 + hstep, voffB); PG8_STAGE(PG8_SA(0, 0), a2, voffA);
            PG8_WAIT_V(8); PG8_WAIT_L(0); PG8_BAR; PG8_MMA(1, 0, At, B0); PG8_MMA(1, 1, At, B1); PG8_BAR; PG8_SCHED;
            PG8_LDB(B0, 1, 0); PG8_LDB(B1, 1, 1); PG8_SCHED; PG8_LDA(At, 1, 0); PG8_STAGE(PG8_SA(0, 1), a2 + hstep, voffA);
            PG8_WAIT_V(8); PG8_WAIT_L(0); PG8_BAR; PG8_MMA(0, 0, At, B0); PG8_MMA(0, 1, At, B1); PG8_BAR; PG8_SCHED;
            PG8_LDA(At, 1, 1); PG8_STAGE(PG8_SB(1, 0), b3, voffB); PG8_STAGE(PG8_SB(1, 1), b3 + hstep, voffB); PG8_STAGE(PG8_SA(1, 0), a3, voffA);
            PG8_WAIT_V(8); PG8_WAIT_L(0); PG8_BAR; PG8_MMA(1, 0, At, B0); PG8_MMA(1, 1, At, B1); PG8_BAR; PG8_SCHED;
        }
        if (wr == 0) PG8_BAR;
        E(acc, cur, wr, wc, fr, fq);
        if (!has_next) break;
#pragma unroll
        for (int a = 0; a < 2; ++a)
#pragma unroll
            for (int b = 0; b < 2; ++b)
#pragma unroll
                for (int m = 0; m < 4; ++m)
#pragma unroll
                    for (int n = 0; n < 2; ++n) acc[a][b][m][n] = (f32x4){0.f, 0.f, 0.f, 0.f};
        cur = nxt; cA = nA; cB = nB; ++ui;
        if (wr == 1) PG8_BAR;
    }
    PG8_WAIT_V(0);
    PG8_BAR;
#undef PG8_SA
#undef PG8_SB
#undef PG8_STAGE
#undef PG8_LDA
#undef PG8_LDB
#undef PG8_MMA
#undef PG8_WAIT_V
#undef PG8_WAIT_L
#undef PG8_BAR
#undef PG8_SCHED
}
}

#define XB_TMO      128
#define XB_XCNT(j)  (256  + 64 * (j))
#define XB_XSUB(j)  (1280 + 64 * (j))
#define XB_XGEN(j)  (2304 + 64 * (j))
#define XB_TOP      3328
#define XB_TOPGEN   3392
#define XCD_BAR_WORDS 3456
#define XB_SPIN_CAP (1u << 18)

__device__ __forceinline__ unsigned xb_ld(unsigned* p)              { return __hip_atomic_load(p, __ATOMIC_RELAXED, __HIP_MEMORY_SCOPE_AGENT); }
__device__ __forceinline__ unsigned xb_add(unsigned* p, unsigned v) { return __hip_atomic_fetch_add(p, v, __ATOMIC_RELAXED, __HIP_MEMORY_SCOPE_AGENT); }
__device__ __forceinline__ unsigned xb_xcc_id() { return (unsigned)__builtin_amdgcn_s_getreg((3 << 11) | 20) & 0xFu; }
#define XB_SPIN(cond, bar) do { unsigned _sp = 0; while (cond) { __builtin_amdgcn_s_sleep(1); \
    if ((++_sp & 255u) == 0u) { if (xb_ld(&(bar)[XB_TMO])) break; if (_sp > XB_SPIN_CAP) { atomicAdd(&(bar)[XB_TMO], 1u); break; } } } } while (0)

struct XcdBarrier {
    unsigned* bar; unsigned x;
    volatile LAS unsigned* st;
};

__device__ __forceinline__ XcdBarrier xcd_barrier_post(unsigned* bar, volatile LAS unsigned* st) {
    XcdBarrier b; b.bar = bar; b.x = xb_xcc_id(); b.st = st;
    if (threadIdx.x == 0) (void)xb_add(&bar[XB_XCNT(b.x)], 1u);
    return b;
}
__device__ __forceinline__ void xcd_barrier_complete(unsigned* bar, unsigned x, unsigned& nloc, unsigned& nx) {
    const unsigned G = gridDim.x * gridDim.y * gridDim.z;
    unsigned sum, cnt, mine, sp = 0u;
    for (;;) {
        sum = 0u; cnt = 0u; mine = 0u;
#pragma unroll
        for (unsigned j = 0; j < 16; ++j) { const unsigned c = xb_ld(&bar[XB_XCNT(j)]); sum += c; cnt += (c > 0u) ? 1u : 0u; mine = (j == x) ? c : mine; }
        if (sum == G) break;
        __builtin_amdgcn_s_sleep(1);
        if ((++sp & 255u) == 0u) { if (xb_ld(&bar[XB_TMO])) break; if (sp > XB_SPIN_CAP) { atomicAdd(&bar[XB_TMO], 1u); break; } }
    }
    nloc = mine > 0u ? mine : 1u; nx = cnt > 0u ? cnt : 1u;
}

__device__ __forceinline__ void xcd_barrier(const XcdBarrier& b) {
    asm volatile("s_waitcnt vmcnt(0)" ::: "memory");
    __syncthreads();
    if (threadIdx.x == 0) {
        unsigned* bar = b.bar;
        __builtin_amdgcn_s_waitcnt(0);
        unsigned nloc = b.st[0], nx = b.st[1];
        if (nloc == 0u) { xcd_barrier_complete(bar, b.x, nloc, nx); b.st[0] = nloc; b.st[1] = nx; }
        const unsigned old = xb_add(&bar[XB_XSUB(b.x)], 1u);
        const unsigned gen = old / nloc;
        if (old + 1u == (gen + 1u) * nloc) {
            __builtin_amdgcn_fence(__ATOMIC_RELEASE, "agent");
            asm volatile("s_waitcnt vmcnt(0)" ::: "memory");
            const unsigned og = xb_add(&bar[XB_TOP], 1u);
            const unsigned tg = og / nx;
            if (og + 1u == (tg + 1u) * nx) xb_add(&bar[XB_TOPGEN], 1u);
            else XB_SPIN(xb_ld(&bar[XB_TOPGEN]) == tg, bar);
            __builtin_amdgcn_fence(__ATOMIC_ACQUIRE, "agent");
            xb_add(&bar[XB_XGEN(b.x)], 1u);
            asm volatile("s_waitcnt vmcnt(0)" ::: "memory");
        } else {
            XB_SPIN(xb_ld(&bar[XB_XGEN(b.x)]) == gen, bar);
            __builtin_amdgcn_fence(__ATOMIC_ACQUIRE, "agent");
            asm volatile("s_waitcnt vmcnt(0)" ::: "memory");
        }
    }
    __syncthreads();
}


__device__ __forceinline__ float wave_sum(float v) {
#pragma unroll
    for (int o = 1; o < 64; o <<= 1) v += __shfl_xor(v, o);
    return v;
}
__device__ __forceinline__ unsigned pk2(float lo, float hi) { return pg8::cvt_pk_bf16(lo, hi); }
__device__ __forceinline__ int rel_bucket(int rel) {
    const int n = rel < 0 ? -rel : rel;
    const int v = n < 8 ? n : 8 + (n >= 15) + (n >= 27) + (n >= 50) + (n >= 91) + (n >= 166) + (n >= 305) + (n >= 559);
    return (rel > 0 ? 16 : 0) + v;
}

__device__ __forceinline__ void transpose_item(const float* W, int K, int N, const float* gain, bf16_t* WT, int mode, LAS float* scr, int item, int lane) {
    const int nblk = N / 32, kb = item / nblk, nb = item % nblk, k0 = 64 * kb, n0 = 32 * nb;
#pragma unroll 8
    for (int i = 0; i < 32; ++i) { const int kk = 2 * i + (lane >> 5); float w = W[(size_t)(k0 + kk) * N + n0 + (lane & 31)]; if (gain) w *= gain[k0 + kk]; scr[kk * 33 + (lane & 31)] = w; }
    asm volatile("s_waitcnt lgkmcnt(0)" ::: "memory");
    const int c = lane & 7;
    const int d0 = (mode == 0) ? n0 : ((n0 >> 7) * 256 + (n0 & 127) + (mode == 2 ? 128 : 0));
#pragma unroll
    for (int j = 0; j < 4; ++j) { const int n = (lane >> 3) + 8 * j; const LAS float* s = scr + (8 * c) * 33 + n;
        u32x4 o; o.x = pk2(s[0 * 33], s[1 * 33]); o.y = pk2(s[2 * 33], s[3 * 33]); o.z = pk2(s[4 * 33], s[5 * 33]); o.w = pk2(s[6 * 33], s[7 * 33]);
        *(u32x4*)(WT + (size_t)(d0 + n) * K + k0 + 8 * c) = o; }
    asm volatile("s_waitcnt lgkmcnt(0)" ::: "memory");
}

constexpr int ATT_TB_OFF = 73728, ATT_TB_N = 384;
constexpr int ATT_V_OFF = 36864;
template <bool DIL>
__device__ __forceinline__ void attn_unit(LAS unsigned char* lds, const int tid, const bf16_t* proj, const float* rel, const float* sink, bf16_t* obuf, unsigned char* ws, int u) {
    constexpr int PPK = DIL ? 32 : 8;
    constexpr int NIT = DIL ? 4 : 1;
    constexpr int KS = DIL ? 528 : 144;
    constexpr int VS = DIL ? 576 : 192;
    constexpr int WIN = DIL ? 64 : 128;
    constexpr int KFIRST = -WIN;
    constexpr int NCH = DIL ? 3 : 5;
    const int lane = tid & 63, wid = __builtin_amdgcn_readfirstlane(tid >> 6);
    const int hl = wid >> 1, qh = wid & 1, r = lane & 31, h = lane >> 5;
    int b, br = 0, sh = 0, rho = 0, q0, Ls, qcol, kcol, vcol, bhead, ocol; bf16_t* op; long ostride;
    if (DIL) {
        const int hg = u & 1, blk = (u >> 1) & 63, rest = u >> 7; br = rest % 3; b = rest / 3; sh = 2 * br;
        const int nb = 64 >> sh; rho = blk >> (6 - sh); q0 = 64 * (blk & (nb - 1)); Ls = SEQ >> sh;
        qcol = hg * 256; kcol = 512 + hg * 256; vcol = 1024 + hg * 256; bhead = hg * 4; ocol = hg * 256;
        op = (br == 2) ? (bf16_t*)(ws + WS_OP2) : (bf16_t*)(ws + WS_XB + (size_t)br * OP_BYTES); ostride = 512;
    } else {
        const int kvh = u & 1, tile = (u >> 1) & 63; b = u >> 7; q0 = 64 * tile; Ls = SEQ;
        qcol = 1536 + kvh * 256; kcol = 2048 + kvh * 64; vcol = 2176 + kvh * 64; bhead = 8 + kvh * 4; ocol = 512 + kvh * 256;
        op = obuf; ostride = 1024;
    }
    const int d = 1 << sh;
    const size_t tok0 = (size_t)b * SEQ + rho;
    const size_t tstride = (size_t)d * NQKV;
    LAS float* tb = (LAS float*)(lds + ATT_TB_OFF);
    __syncthreads();
    for (int e = tid; e < 4 * ATT_TB_N; e += 512) {
        const int hh = e / ATT_TB_N, idx = e % ATT_TB_N, delta = idx - 191;
        float v = -1e30f;
        if (delta >= -WIN && delta <= WIN) v = rel[rel_bucket(delta * d) * 16 + bhead + hh] * LOG2E;
        tb[e] = v;
    }
    bf16x8 qf[4];
    {
        const bf16_t* qrow = proj + (tok0 + (size_t)(q0 + 32 * qh + r) * d) * NQKV + qcol + hl * 64 + 8 * h;
#pragma unroll
        for (int s = 0; s < 4; ++s) qf[s] = *(const bf16x8*)(qrow + 16 * s);
    }
    int c_lo = 0, c_hi = NCH - 1;
    while (q0 + KFIRST + 64 * c_lo < 0) ++c_lo;
    while (q0 + KFIRST + 64 * c_hi >= Ls) --c_hi;
    u32x4 kreg[NIT], vreg[NIT];
    const bf16_t* kbase = proj + tok0 * NQKV;
#define ATT_PREFETCH(c) do { const int ks0 = q0 + KFIRST + 64 * (c); _Pragma("unroll") for (int i = 0; i < NIT; ++i) { const int p = tid + 512 * i, key = p / PPK, hc = p % PPK; \
        const bf16_t* src = kbase + (size_t)(ks0 + key) * tstride + hc * 8; kreg[i] = *(const u32x4*)(src + kcol); vreg[i] = *(const u32x4*)(src + vcol); } } while (0)
    ATT_PREFETCH(c_lo);
    float m_run, l_run;
    if (DIL) { m_run = -1e30f; l_run = 0.f; } else { m_run = sink[(bhead - 8) + hl] * LOG2E; l_run = (h == 0) ? 1.0f : 0.0f; }
    f32x16 o0, o1;
#pragma unroll
    for (int i = 0; i < 16; ++i) { o0[i] = 0.f; o1[i] = 0.f; }
    const int hlk = DIL ? hl : 0;
    const LAS unsigned char* kread = lds + r * KS + hlk * 128 + 16 * h;
    const LAS unsigned char* vread = lds + ATT_V_OFF + (4 * h + ((lane & 15) >> 2)) * VS + (hlk * 64 + 16 * ((lane >> 4) & 1) + 4 * (lane & 3)) * 2;
    for (int c = c_lo; c <= c_hi; ++c) {
        __syncthreads();
#pragma unroll
        for (int i = 0; i < NIT; ++i) { const int p = tid + 512 * i, key = p / PPK, hc = p % PPK;
            *(LAS u32x4*)(lds + key * KS + hc * 16) = kreg[i]; *(LAS u32x4*)(lds + ATT_V_OFF + key * VS + hc * 16) = vreg[i]; }
        __syncthreads();
        if (c < c_hi) ATT_PREFETCH(c + 1);
        f32x16 x0, x1;
#pragma unroll
        for (int i = 0; i < 16; ++i) { x0[i] = 0.f; x1[i] = 0.f; }
#pragma unroll
        for (int s = 0; s < 4; ++s) {
            const bf16x8 a0 = *(const LAS bf16x8*)(kread + s * 32), a1 = *(const LAS bf16x8*)(kread + 32 * KS + s * 32);
            x0 = __builtin_amdgcn_mfma_f32_32x32x16_bf16(a0, qf[s], x0, 0, 0, 0);
            x1 = __builtin_amdgcn_mfma_f32_32x32x16_bf16(a1, qf[s], x1, 0, 0, 0);
        }
        const LAS float* tbp = tb + hl * ATT_TB_N + (KFIRST + 64 * c + 191 + 4 * h - 32 * qh - r);
        float mx = -1e30f;
#pragma unroll
        for (int i = 0; i < 16; ++i) { const int ko = (i & 3) + 8 * (i >> 2); x0[i] += tbp[ko]; x1[i] += tbp[32 + ko]; mx = fmaxf(mx, fmaxf(x0[i], x1[i])); }
        mx = fmaxf(mx, __shfl_xor(mx, 32));
        const float m_new = fmaxf(m_run, mx), alpha = __builtin_amdgcn_exp2f(m_run - m_new); m_run = m_new;
        float rsum = 0.f;
#pragma unroll
        for (int i = 0; i < 16; ++i) { x0[i] = __builtin_amdgcn_exp2f(x0[i] - m_new); x1[i] = __builtin_amdgcn_exp2f(x1[i] - m_new); rsum += x0[i] + x1[i]; }
        l_run = l_run * alpha + rsum;
#pragma unroll
        for (int i = 0; i < 16; ++i) { o0[i] *= alpha; o1[i] *= alpha; }
#pragma unroll
        for (int kb = 0; kb < 2; ++kb)
#pragma unroll
            for (int s = 0; s < 2; ++s) {
                u32x4 pw;
                if (kb == 0) { pw.x = pk2(x0[8 * s + 0], x0[8 * s + 1]); pw.y = pk2(x0[8 * s + 2], x0[8 * s + 3]); pw.z = pk2(x0[8 * s + 4], x0[8 * s + 5]); pw.w = pk2(x0[8 * s + 6], x0[8 * s + 7]); }
                else         { pw.x = pk2(x1[8 * s + 0], x1[8 * s + 1]); pw.y = pk2(x1[8 * s + 2], x1[8 * s + 3]); pw.z = pk2(x1[8 * s + 4], x1[8 * s + 5]); pw.w = pk2(x1[8 * s + 6], x1[8 * s + 7]); }
                const bf16x8 pb = __builtin_bit_cast(bf16x8, pw);
                const LAS unsigned char* vp = vread + (32 * kb + 16 * s) * VS;
                const s16x4 lo0 = __builtin_bit_cast(s16x4, __builtin_amdgcn_ds_read_tr16_b64_v4i16((LAS s16x4*)(vp)));
                const s16x4 hi0 = __builtin_bit_cast(s16x4, __builtin_amdgcn_ds_read_tr16_b64_v4i16((LAS s16x4*)(vp + 8 * VS)));
                const s16x4 lo1 = __builtin_bit_cast(s16x4, __builtin_amdgcn_ds_read_tr16_b64_v4i16((LAS s16x4*)(vp + 64)));
                const s16x4 hi1 = __builtin_bit_cast(s16x4, __builtin_amdgcn_ds_read_tr16_b64_v4i16((LAS s16x4*)(vp + 64 + 8 * VS)));
                const bf16x8 va0 = (bf16x8){lo0[0], lo0[1], lo0[2], lo0[3], hi0[0], hi0[1], hi0[2], hi0[3]};
                const bf16x8 va1 = (bf16x8){lo1[0], lo1[1], lo1[2], lo1[3], hi1[0], hi1[1], hi1[2], hi1[3]};
                o0 = __builtin_amdgcn_mfma_f32_32x32x16_bf16(va0, pb, o0, 0, 0, 0);
                o1 = __builtin_amdgcn_mfma_f32_32x32x16_bf16(va1, pb, o1, 0, 0, 0);
            }
    }
#undef ATT_PREFETCH
    const float l_tot = l_run + __shfl_xor(l_run, 32);
    const float inv = 1.0f / l_tot;
    const size_t tok = tok0 + (size_t)(q0 + 32 * qh + r) * d;
    bf16_t* orow = op + tok * ostride + ocol + hl * 64 + 4 * h;
#pragma unroll
    for (int g4 = 0; g4 < 4; ++g4) {
        u32x2 w0, w1;
        w0.x = pk2(o0[4 * g4 + 0] * inv, o0[4 * g4 + 1] * inv); w0.y = pk2(o0[4 * g4 + 2] * inv, o0[4 * g4 + 3] * inv);
        w1.x = pk2(o1[4 * g4 + 0] * inv, o1[4 * g4 + 1] * inv); w1.y = pk2(o1[4 * g4 + 2] * inv, o1[4 * g4 + 3] * inv);
        *(u32x2*)(orow + 8 * g4) = w0; *(u32x2*)(orow + 32 + 8 * g4) = w1;
    }
    if (DIL && h == 0) { float* lse = (float*)(ws + WS_LSE); lse[((size_t)br * T + tok) * 8 + bhead + hl] = m_run + __builtin_amdgcn_logf(l_tot); }
}

struct Args { const float* in[16]; float* out; unsigned char* ws; int ph_lo, ph_hi, coop, pad; };
constexpr int LDS_BYTES = 147456;
constexpr int N_PHASES = 18;

__global__ void __launch_bounds__(512, 2) fwd_mega(Args args) {
    extern __shared__ __attribute__((aligned(16))) unsigned char lds_raw[];
    LAS unsigned char* lds = (LAS unsigned char*)lds_raw;
    cg::grid_group grid = cg::this_grid();
    const int ph_hi = args.ph_hi, coop = args.coop;
    if (threadIdx.x < 2) ((LAS unsigned*)(lds + LDS_BARST_OFF))[threadIdx.x] = 0u;
    __syncthreads();
    XcdBarrier xbar; xbar.bar = (unsigned*)(args.ws + WS_BAR); xbar.x = 0; xbar.st = (volatile LAS unsigned*)(lds + LDS_BARST_OFF);
    bool posted = false;
    for (int ph = args.ph_lo; ph < ph_hi; ++ph) {
        int tid = threadIdx.x; asm volatile("" : "+v"(tid));
        int bidx = blockIdx.x; asm volatile("" : "+s"(bidx));
        const __attribute__((address_space(4))) Args* ap = (const __attribute__((address_space(4))) Args*)__builtin_amdgcn_kernarg_segment_ptr(); asm volatile("" : "+s"(ap));
        const int lane = tid & 63, wave = __builtin_amdgcn_readfirstlane(tid >> 6);
        const int G = gridDim.x, gw = bidx * 8 + wave, NGW = G * 8;
        unsigned char* ws = ap->ws;
        float* ssb = (float*)(ws + WS_SS);
        bf16_t* XB = (bf16_t*)(ws + WS_XB); bf16_t* OB = (bf16_t*)(ws + WS_O); bf16_t* HB = (bf16_t*)(ws + WS_H);
        float* out = ap->out;
        if (ph == 0) {
            LAS float* scr = (LAS float*)(lds + wave * 16384);
            constexpr int I_GU = (DM / 64) * (FF / 32), I_DN = (FF / 64) * (DM / 32), I_IN = (DM / 64) * (NQKV / 32), I_WO = (DM / 64) * (DM / 32);
            constexpr int I_LAYER = 4 * I_GU + 2 * I_DN + I_IN + I_WO;
            for (int it = gw; it < 2 * I_LAYER; it += NGW) {
                const int l = it / I_LAYER; int rr = it % I_LAYER;
                unsigned char* wl = ws + WS_W + (size_t)l * WL_BYTES;
                if (rr < I_GU) { transpose_item(ap->in[4] + (size_t)l * DM * FF, DM, FF, ap->in[3] + l * DM, (bf16_t*)(wl + WL_W1A), 1, scr, rr, lane); continue; } rr -= I_GU;
                if (rr < I_GU) { transpose_item(ap->in[5] + (size_t)l * DM * FF, DM, FF, ap->in[3] + l * DM, (bf16_t*)(wl + WL_W1A), 2, scr, rr, lane); continue; } rr -= I_GU;
                if (rr < I_DN) { transpose_item(ap->in[6] + (size_t)l * FF * DM, FF, DM, nullptr, (bf16_t*)(wl + WL_W2A), 0, scr, rr, lane); continue; } rr -= I_DN;
                if (rr < I_GU) { transpose_item(ap->in[12] + (size_t)l * DM * FF, DM, FF, ap->in[11] + l * DM, (bf16_t*)(wl + WL_W1B), 1, scr, rr, lane); continue; } rr -= I_GU;
                if (rr < I_GU) { transpose_item(ap->in[13] + (size_t)l * DM * FF, DM, FF, ap->in[11] + l * DM, (bf16_t*)(wl + WL_W1B), 2, scr, rr, lane); continue; } rr -= I_GU;
                if (rr < I_DN) { transpose_item(ap->in[14] + (size_t)l * FF * DM, FF, DM, nullptr, (bf16_t*)(wl + WL_W2B), 0, scr, rr, lane); continue; } rr -= I_DN;
                if (rr < I_IN) { transpose_item(ap->in[8] + (size_t)l * DM * NQKV, DM, NQKV, ap->in[7] + l * DM, (bf16_t*)(wl + WL_WIN), 0, scr, rr, lane); continue; } rr -= I_IN;
                transpose_item(ap->in[9] + (size_t)l * DM * DM, DM, DM, nullptr, (bf16_t*)(wl + WL_WO), 0, scr, rr, lane);
            }
            for (int row = gw; row < T; row += NGW) {
                const float* src = (row >= TP) ? ap->in[1] + (size_t)(row - TP) * DM : ap->in[0] + (size_t)row * DM;
                const f32x4* xr = (const f32x4*)src + lane; f32x4 v[4]; float s = 0.f;
#pragma unroll
                for (int j = 0; j < 4; ++j) { v[j] = xr[64 * j]; s += (v[j][0] * v[j][0] + v[j][1] * v[j][1]) + (v[j][2] * v[j][2] + v[j][3] * v[j][3]); }
                s = wave_sum(s);
                u32x2* o8 = (u32x2*)(XB + (size_t)row * DM) + lane;
#pragma unroll
                for (int j = 0; j < 4; ++j) { u32x2 w; w.x = pk2(v[j][0], v[j][1]); w.y = pk2(v[j][2], v[j][3]); o8[64 * j] = w; }
                if (lane == 0) ssb[row] = s;
            }
            for (int i = bidx * 512 + tid; i < 6 * T; i += G * 512) ssb[T + i] = 0.f;
            if (bidx == 0) { unsigned* bw = (unsigned*)(ws + WS_BAR); for (int i = tid; i < XCD_BAR_WORDS; i += 512) bw[i] = 0u; }
        } else if (ph == N_PHASES - 1) {
            const float* ss = ssb + 6 * (size_t)T; const float* gf = ap->in[15];
            f32x4 gv[4];
#pragma unroll
            for (int j = 0; j < 4; ++j) gv[j] = ((const f32x4*)gf)[lane + 64 * j];
            for (int row = gw; row < T; row += NGW) {
                const float rs = __builtin_amdgcn_rsqf(ss[row] * (1.0f / 1024.0f) + EPS);
                f32x4* xr = (f32x4*)(out + (size_t)row * DM) + lane;
#pragma unroll
                for (int j = 0; j < 4; ++j) { f32x4 v = xr[64 * j]; v = v * rs * gv[j]; xr[64 * j] = v; }
            }
        } else {
            const int l = (ph - 1) >> 3, k = (ph - 1) & 7;
            unsigned char* wl = ws + WS_W + (size_t)l * WL_BYTES;
            if (k == 0 || k == 6) {
                const float* ss = ssb + (size_t)(3 * l + (k == 0 ? 0 : 2)) * T;
                pg8::Gemm g{XB, (const bf16_t*)(wl + (k == 0 ? WL_W1A : WL_W1B)), T, 2 * FF, DM};
                pg8::StaticOrder S; S.init(T, 2 * FF, G, bidx);
                pg8::EpiSwiGLU E{HB, ss};
                pg8::gemm_phase<pg8::EpiSwiGLU, pg8::StaticOrder>(lds, tid, g, S, E);
            } else if (k == 1 || k == 7 || k == 5) {
                const bool first = (l == 0 && k == 1);
                const float* sA = first ? ap->in[0] : out; const float* sB = first ? ap->in[1] : out + (size_t)TP * DM;
                float* ssn = ssb + (size_t)(3 * l + (k == 1 ? 1 : (k == 5 ? 2 : 3))) * T;
                if (k == 5) {
                    pg8::Gemm g{OB, (const bf16_t*)(wl + WL_WO), T, DM, DM};
                    pg8::StaticOrder S; S.init(T, DM, G, bidx);
                    pg8::EpiRes E{sA, sB, out, XB, ssn, 1.0f};
                    pg8::gemm_phase<pg8::EpiRes, pg8::StaticOrder>(lds, tid, g, S, E);
                } else {
                    pg8::Gemm g{HB, (const bf16_t*)(wl + (k == 1 ? WL_W2A : WL_W2B)), T, DM, FF};
                    pg8::StaticOrder S; S.init(T, DM, G, bidx);
                    pg8::EpiRes E{sA, sB, out, XB, ssn, 0.5f};
                    pg8::gemm_phase<pg8::EpiRes, pg8::StaticOrder>(lds, tid, g, S, E);
                }
            } else if (k == 2) {
                const float* ss = ssb + (size_t)(3 * l + 1) * T;
                pg8::Gemm g{XB, (const bf16_t*)(wl + WL_WIN), T, NQKV, DM};
                pg8::StaticOrder S; S.init(T, NQKV, G, bidx);
                pg8::EpiQKV E{HB, ss};
                pg8::gemm_phase<pg8::EpiQKV, pg8::StaticOrder>(lds, tid, g, S, E);
            } else if (k == 3) {
                const float* rel = ap->in[2]; const float* sink = ap->in[10] + l * 8;
                for (int i = bidx; i < 2560 + 7680; i += G) {
                    if (i < 2560) attn_unit<false>(lds, tid, HB, rel, sink, OB, ws, i);
                    else attn_unit<true>(lds, tid, HB, rel, sink, OB, ws, i - 2560);
                }
                __syncthreads();
            } else {
                const float* lse = (const float*)(ws + WS_LSE);
                const bf16_t* p0 = (const bf16_t*)(ws + WS_XB); const bf16_t* p1 = (const bf16_t*)(ws + WS_XB + OP_BYTES); const bf16_t* p2 = (const bf16_t*)(ws + WS_OP2);
                for (size_t idx = (size_t)bidx * 512 + tid; idx < (size_t)T * 64; idx += (size_t)G * 512) {
                    const size_t tok = idx >> 6; const int hd = (int)(idx >> 3) & 7, c8 = (int)idx & 7;
                    const float l0 = lse[tok * 8 + hd], l1 = lse[((size_t)T + tok) * 8 + hd], l2 = lse[((size_t)2 * T + tok) * 8 + hd];
                    const float mx = fmaxf(l0, fmaxf(l1, l2));
                    float w0 = __builtin_amdgcn_exp2f(l0 - mx), w1 = __builtin_amdgcn_exp2f(l1 - mx), w2 = __builtin_amdgcn_exp2f(l2 - mx);
                    const float inv = 1.0f / (w0 + w1 + w2); w0 *= inv; w1 *= inv; w2 *= inv;
                    const size_t off = tok * 512 + hd * 64 + c8 * 8;
                    const u32x4 a = *(const u32x4*)(p0 + off), bq = *(const u32x4*)(p1 + off), cq = *(const u32x4*)(p2 + off);
                    u32x4 o;
#pragma unroll
                    for (int j = 0; j < 4; ++j) {
                        const float a_lo = __uint_as_float(a[j] << 16), a_hi = __uint_as_float(a[j] & 0xffff0000u);
                        const float b_lo = __uint_as_float(bq[j] << 16), b_hi = __uint_as_float(bq[j] & 0xffff0000u);
                        const float c_lo = __uint_as_float(cq[j] << 16), c_hi = __uint_as_float(cq[j] & 0xffff0000u);
                        o[j] = pk2(w0 * a_lo + w1 * b_lo + w2 * c_lo, w0 * a_hi + w1 * b_hi + w2 * c_hi);
                    }
                    *(u32x4*)(OB + tok * 1024 + hd * 64 + c8 * 8) = o;
                }
            }
        }
        if (ph + 1 < ph_hi && coop) {
            if (!posted) { grid.sync(); xbar = xcd_barrier_post((unsigned*)(args.ws + WS_BAR), (volatile LAS unsigned*)(lds + LDS_BARST_OFF)); posted = true; }
            else xcd_barrier(xbar);
        }
    }
}

extern "C" void kernel_launch(void* const* d_in, const int* in_sizes, int n_in, void* d_out, int out_size, void* d_ws, size_t ws_size, hipStream_t stream) {
    static int grid = 0;
    if (grid == 0) {
        if (n_in != 16 || out_size != T * DM || ws_size < WS_END) { fprintf(stderr, "kernel_launch: unexpected shapes (n_in %d out %d ws %zu)\n", n_in, out_size, ws_size); grid = -1; return; }
        int dev = 0, cus = 0, per_cu = 0;
        hipGetDevice(&dev); hipDeviceGetAttribute(&cus, hipDeviceAttributeMultiprocessorCount, dev);
        if (hipFuncSetAttribute((const void*)fwd_mega, hipFuncAttributeMaxDynamicSharedMemorySize, LDS_BYTES) != hipSuccess) { fprintf(stderr, "kernel_launch: hipFuncSetAttribute failed\n"); grid = -1; return; }
        if (hipOccupancyMaxActiveBlocksPerMultiprocessor(&per_cu, (const void*)fwd_mega, 512, LDS_BYTES) != hipSuccess || per_cu < 1) per_cu = 1;
        (void)hipGetLastError();
        grid = cus * per_cu;
    }
    if (grid < 0) return;
    Args a{};
    for (int i = 0; i < 16; ++i) a.in[i] = (const float*)d_in[i];
    a.out = (float*)d_out; a.ws = (unsigned char*)d_ws;
#if MK_PER_PHASE
    for (int ph = 0; ph < N_PHASES; ++ph) {
        a.ph_lo = ph; a.ph_hi = ph + 1; a.coop = 0;
        hipLaunchKernelGGL(fwd_mega, dim3(grid), dim3(512), LDS_BYTES, stream, a);
    }
#else
    a.ph_lo = 0; a.ph_hi = N_PHASES; a.coop = 1;
    void* kargs[] = {&a};
    hipError_t e = hipLaunchCooperativeKernel((const void*)fwd_mega, dim3(grid), dim3(512), kargs, LDS_BYTES, stream);
    if (e != hipSuccess) fprintf(stderr, "cooperative launch failed: %s (grid %d)\n", hipGetErrorString(e), grid);
#endif
}
```

```cpp
#include <hip/hip_runtime.h>
#include <hip/hip_cooperative_groups.h>
#include <cstdio>
#include <cstdint>
namespace cg = cooperative_groups;

#ifndef MK_PER_PHASE
#define MK_PER_PHASE 0
#endif

#define LAS __attribute__((address_space(3)))
typedef unsigned short bf16_t;
typedef short bf16x8 __attribute__((ext_vector_type(8)));
typedef float f32x4 __attribute__((ext_vector_type(4)));
typedef float f32x16 __attribute__((ext_vector_type(16)));
typedef unsigned u32x4 __attribute__((ext_vector_type(4)));
typedef unsigned u32x2 __attribute__((ext_vector_type(2)));
typedef short s16x4 __attribute__((ext_vector_type(4)));

constexpr int T = 81920, TP = 65536, DM = 1024, FF = 2816, NQKV = 2304, SEQ = 4096, NSEQ = 20;
constexpr float EPS = 1e-6f, LOG2E = 1.4426950408889634f;
constexpr float QSCALE = 0.125f * LOG2E;

constexpr size_t MiB = 1u << 20;
constexpr size_t WS_SS = 1 * MiB;
constexpr size_t WS_LSE = 4 * MiB;
constexpr size_t WS_W = 12 * MiB;
constexpr size_t W1_BYTES = (size_t)2 * FF * DM * 2, W2_BYTES = (size_t)DM * FF * 2, WIN_BYTES = (size_t)NQKV * DM * 2, WO_BYTES = (size_t)DM * DM * 2;
constexpr size_t WL_W1A = 0, WL_W2A = WL_W1A + W1_BYTES, WL_WIN = WL_W2A + W2_BYTES, WL_WO = WL_WIN + WIN_BYTES, WL_W1B = WL_WO + WO_BYTES, WL_W2B = WL_W1B + W1_BYTES, WL_BYTES = WL_W2B + W2_BYTES;
constexpr size_t WS_XB = 92 * MiB;
constexpr size_t WS_O = 252 * MiB;
constexpr size_t WS_H = 412 * MiB;
constexpr size_t WS_OP2 = 852 * MiB;
constexpr size_t WS_BAR = 932 * MiB;
constexpr size_t WS_END = 933 * MiB;
constexpr int LDS_BARST_OFF = 131072 + 512;
static_assert(WS_W + 2 * WL_BYTES <= WS_XB, "weights fit");
constexpr size_t OP_BYTES = (size_t)T * 512 * 2;

namespace pg8 {
constexpr int BM = 256, BK = 64, HALF = 128, HTB = HALF * BK * 2, STAGE_BYTES = 8 * HTB, NXCD = 8, WGM = 8;
__host__ __device__ __forceinline__ int lds_byte(int r, int c) { const int st = (r >> 4) * 2 + (c >> 5), rr = r & 15, cc = c & 31, ob = rr * 64 + cc * 2; return st * 1024 + (ob ^ (((ob >> 9) & 1) << 5)); }
__host__ __device__ __forceinline__ void stage_rc(int b, int& R, int& C) { const int st = b / 1024, sb = b % 1024, swz = sb ^ (((sb >> 9) & 1) << 5); R = (st >> 1) * 16 + swz / 64; C = (st & 1) * 32 + (swz % 64) / 2; }
__host__ __device__ __forceinline__ int perm32(int rho) { const int n = rho >> 4, i = rho & 15; return 8 * (i >> 2) + 4 * n + (i & 3); }
struct Unit { int pm, pn; };
struct Gemm { const bf16_t* A; const bf16_t* Bt; int M, N, K; };
struct StaticOrder {
    int nM, nN, nwg, G, c;
    __device__ void init(int M, int N, int G_, int c_) { nM = M / BM; nN = N / BM; nwg = nM * nN; G = G_; c = c_; }
    __device__ bool next(int i, Unit& u) const {
        const long L = (long)i * G + c; if (L >= nwg) return false;
        int wgid = (int)L; { const int q = nwg / NXCD, r = nwg % NXCD, xcd = wgid % NXCD, off = wgid / NXCD; wgid = (xcd < r ? xcd * (q + 1) : r * (q + 1) + (xcd - r) * q) + off; }
        const int nig = WGM * nN, gid = wgid / nig, fm = gid * WGM, gsz = (nM - fm) < WGM ? (nM - fm) : WGM;
        u.pm = fm + ((wgid % nig) % gsz); u.pn = (wgid % nig) / gsz; return true;
    }
};
__device__ __forceinline__ unsigned cvt_pk_bf16(float lo, float hi) { unsigned r; asm volatile("v_cvt_pk_bf16_f32 %0, %1, %2" : "=v"(r) : "v"(lo), "v"(hi)); return r; }

struct EpiSwiGLU {
    static constexpr bool PERM = true;
    bf16_t* H; const float* ss;
    __device__ __forceinline__ void operator()(const f32x4 (&acc)[2][2][4][2], const Unit& u, int wr, int wc, int fr, int fq) const {
        const int row0 = u.pm * BM + wr * 64 + fr; const int col0 = u.pn * 128 + wc * 32 + 8 * fq;
#pragma unroll
        for (int ai = 0; ai < 2; ++ai)
#pragma unroll
            for (int m = 0; m < 4; ++m) {
                const int row = row0 + ai * HALF + m * 16;
                const float rs = __builtin_amdgcn_rsqf(ss[row] * (1.0f / 1024.0f) + EPS);
                float hv[8];
#pragma unroll
                for (int n = 0; n < 2; ++n)
#pragma unroll
                    for (int j = 0; j < 4; ++j) {
                        const float g = acc[ai][0][m][n][j] * rs, up = acc[ai][1][m][n][j] * rs;
                        const float e = __builtin_amdgcn_exp2f(-g * LOG2E);
                        hv[n * 4 + j] = g * __builtin_amdgcn_rcpf(1.0f + e) * up;
                    }
                u32x4 w; w.x = cvt_pk_bf16(hv[0], hv[1]); w.y = cvt_pk_bf16(hv[2], hv[3]); w.z = cvt_pk_bf16(hv[4], hv[5]); w.w = cvt_pk_bf16(hv[6], hv[7]);
                *(u32x4*)(H + (size_t)row * FF + col0) = w;
            }
    }
};
struct EpiQKV {
    static constexpr bool PERM = true;
    bf16_t* P; const float* ss;
    __device__ __forceinline__ void operator()(const f32x4 (&acc)[2][2][4][2], const Unit& u, int wr, int wc, int fr, int fq) const {
        const int row0 = u.pm * BM + wr * 64 + fr; const int col0 = u.pn * BM + wc * 32 + 8 * fq;
        const float cs = (u.pn < 2 || u.pn == 6 || u.pn == 7) ? QSCALE : 1.0f;
#pragma unroll
        for (int ai = 0; ai < 2; ++ai)
#pragma unroll
            for (int m = 0; m < 4; ++m) {
                const int row = row0 + ai * HALF + m * 16;
                const float rs = __builtin_amdgcn_rsqf(ss[row] * (1.0f / 1024.0f) + EPS) * cs;
#pragma unroll
                for (int bj = 0; bj < 2; ++bj) {
                    const f32x4 v0 = acc[ai][bj][m][0] * rs, v1 = acc[ai][bj][m][1] * rs;
                    u32x4 w; w.x = cvt_pk_bf16(v0[0], v0[1]); w.y = cvt_pk_bf16(v0[2], v0[3]); w.z = cvt_pk_bf16(v1[0], v1[1]); w.w = cvt_pk_bf16(v1[2], v1[3]);
                    *(u32x4*)(P + (size_t)row * NQKV + col0 + bj * HALF) = w;
                }
            }
    }
};
struct EpiRes {
    static constexpr bool PERM = true;
    const float* srcA; const float* srcB; float* out; bf16_t* xb; float* ssn; float alpha;
    __device__ __forceinline__ void operator()(const f32x4 (&acc)[2][2][4][2], const Unit& u, int wr, int wc, int fr, int fq) const {
        const int row0 = u.pm * BM + wr * 64 + fr; const int col0 = u.pn * BM + wc * 32 + 8 * fq;
#pragma unroll
        for (int ai = 0; ai < 2; ++ai)
#pragma unroll
            for (int m = 0; m < 4; ++m) {
                const int row = row0 + ai * HALF + m * 16;
                const float* src = (row >= TP) ? srcB + (size_t)(row - TP) * DM : srcA + (size_t)row * DM;
                const size_t off = (size_t)row * DM + col0;
                float s = 0.f;
#pragma unroll
                for (int bj = 0; bj < 2; ++bj) {
                    f32x4 a = *(const f32x4*)(src + col0 + bj * HALF), b = *(const f32x4*)(src + col0 + bj * HALF + 4);
                    a = a + acc[ai][bj][m][0] * alpha; b = b + acc[ai][bj][m][1] * alpha;
                    *(f32x4*)(out + off + bj * HALF) = a; *(f32x4*)(out + off + bj * HALF + 4) = b;
                    u32x4 w; w.x = cvt_pk_bf16(a[0], a[1]); w.y = cvt_pk_bf16(a[2], a[3]); w.z = cvt_pk_bf16(b[0], b[1]); w.w = cvt_pk_bf16(b[2], b[3]);
                    if (xb) *(u32x4*)(xb + off + bj * HALF) = w;
                    s += (a[0] * a[0] + a[1] * a[1]) + (a[2] * a[2] + a[3] * a[3]) + (b[0] * b[0] + b[1] * b[1]) + (b[2] * b[2] + b[3] * b[3]);
                }
                s += __shfl_xor(s, 16); s += __shfl_xor(s, 32);
                if (fq == 0) atomicAdd(ssn + row, s);
                asm volatile("" ::: "memory");
            }
    }
};

template <class Epi, class Sched>
__device__ __forceinline__ void gemm_phase(LAS unsigned char* lds, const int tid, const Gemm g, const Sched& S, const Epi& E) {
    const int wid = __builtin_amdgcn_readfirstlane(tid >> 6), lane = tid & 63, wr = wid >> 2, wc = wid & 3, fr = lane & 15, fq = lane >> 4;
    const int K = g.K, nt = K / BK;
    unsigned voffA[2], voffB[2];
#pragma unroll
    for (int i = 0; i < 2; ++i) { int R, C; stage_rc(tid * 16 + i * 8192, R, C); const int Rb = Epi::PERM ? ((R & ~31) + perm32(R & 31)) : R;
        voffA[i] = (unsigned)(R * K + C) * 2u; voffB[i] = (unsigned)(Rb * K + C) * 2u; }
    const size_t kstep = (size_t)(BK * 2);
    const size_t hstep = (size_t)HALF * K * 2;
    const size_t tstep = 2 * hstep;
    const unsigned ldsw = (unsigned)wid * 1024u;
    const int aoff = lds_byte(wr * 64 + fr, fq * 8), boff = lds_byte(wc * 32 + fr, fq * 8);
#define PG8_SA(b, h) (((b) * 2 + (h)) * HTB)
#define PG8_SB(b, h) ((4 + (b) * 2 + (h)) * HTB)
#define PG8_STAGE(bufoff, gbase, voff) do { _Pragma("unroll") for (int _i = 0; _i < 2; ++_i) \
        __builtin_amdgcn_global_load_lds((const unsigned*)((const char*)(gbase) + (voff)[_i]), (LAS unsigned*)(lds + (bufoff) + ldsw + _i * 8192), 16, 0, 0); } while (0)
#define PG8_LDA(dst, b, h) do { _Pragma("unroll") for (int m = 0; m < 4; ++m) _Pragma("unroll") for (int k = 0; k < 2; ++k) dst[m][k] = *(const LAS bf16x8*)(lds + PG8_SA(b, h) + aoff + m * 2048 + k * 1024); } while (0)
#define PG8_LDB(dst, b, h) do { _Pragma("unroll") for (int n = 0; n < 2; ++n) _Pragma("unroll") for (int k = 0; k < 2; ++k) dst[n][k] = *(const LAS bf16x8*)(lds + PG8_SB(b, h) + boff + n * 2048 + k * 1024); } while (0)
#define PG8_MMA(ai, bj, At, Bt) do { __builtin_amdgcn_s_setprio(1); _Pragma("unroll") for (int m = 0; m < 4; ++m) _Pragma("unroll") for (int n = 0; n < 2; ++n) _Pragma("unroll") for (int k = 0; k < 2; ++k) \
        acc[ai][bj][m][n] = __builtin_amdgcn_mfma_f32_16x16x32_bf16(Bt[n][k], At[m][k], acc[ai][bj][m][n], 0, 0, 0); __builtin_amdgcn_s_setprio(0); } while (0)
#define PG8_WAIT_V(n) asm volatile("s_waitcnt vmcnt(" #n ")" ::: "memory")
#define PG8_WAIT_L(n) asm volatile("s_waitcnt lgkmcnt(" #n ")" ::: "memory")
#define PG8_BAR __builtin_amdgcn_s_barrier()
#define PG8_SCHED __builtin_amdgcn_sched_barrier(0)
    Unit cur, nxt; int ui = 0;
    if (!S.next(0, cur)) return;
    f32x4 acc[2][2][4][2];
#pragma unroll
    for (int a = 0; a < 2; ++a)
#pragma unroll
        for (int b = 0; b < 2; ++b)
#pragma unroll
            for (int m = 0; m < 4; ++m)
#pragma unroll
                for (int n = 0; n < 2; ++n) acc[a][b][m][n] = (f32x4){0.f, 0.f, 0.f, 0.f};
    bf16x8 At[4][2], B0[2][2], B1[2][2];
    const char* cA = (const char*)g.A + (size_t)cur.pm * tstep; const char* cB = (const char*)g.Bt + (size_t)cur.pn * tstep;
    PG8_STAGE(PG8_SB(0, 0), cB, voffB); PG8_STAGE(PG8_SB(0, 1), cB + hstep, voffB); PG8_STAGE(PG8_SA(0, 0), cA, voffA); PG8_STAGE(PG8_SA(0, 1), cA + hstep, voffA);
    if (wr == 1) PG8_BAR;
    PG8_WAIT_V(2); PG8_BAR;
    PG8_STAGE(PG8_SB(1, 0), cB + kstep, voffB); PG8_STAGE(PG8_SA(1, 0), cA + kstep, voffA); PG8_STAGE(PG8_SB(1, 1), cB + hstep + kstep, voffB);
    PG8_WAIT_V(6); PG8_BAR;
    for (;;) {
        const bool has_next = S.next(ui + 1, nxt);
        const char* nA = has_next ? (const char*)g.A + (size_t)nxt.pm * tstep : cA; const char* nB = has_next ? (const char*)g.Bt + (size_t)nxt.pn * tstep : cB;
        for (int t = 0; t < nt; t += 2) {
            const bool last = (t == nt - 2);
            const char* a1 = cA + (size_t)(t + 1) * kstep;
            const char* a2 = last ? nA : cA + (size_t)(t + 2) * kstep; const char* b2 = last ? nB : cB + (size_t)(t + 2) * kstep;
            const char* a3 = a2 + kstep; const char* b3 = b2 + kstep;
            PG8_LDB(B0, 0, 0); PG8_LDB(B1, 0, 1); PG8_SCHED; PG8_LDA(At, 0, 0); PG8_STAGE(PG8_SA(1, 1), a1 + hstep, voffA);
            PG8_WAIT_V(8); PG8_WAIT_L(0); PG8_BAR; PG8_MMA(0, 0, At, B0); PG8_MMA(0, 1, At, B1); PG8_BAR; PG8_SCHED;
            PG8_LDA(At, 0, 1); PG8_STAGE(PG8_SB(0, 0), b2, voffB); PG8_STAGE(PG8_SB(0, 1), b2 + hstep, voffB); PG8_STAGE(PG8_SA(0, 0), a2, voffA);
            PG8_WAIT_V(8); PG8_WAIT_L(0); PG8_BAR; PG8_MMA(1, 0, At, B0); PG8_MMA(1, 1, At, B1); PG8_BAR; PG8_SCHED;
            PG8_LDB(B0, 1, 0); PG8_LDB(B1, 1, 1); PG8_SCHED; PG8_LDA(At, 1, 0); PG8_STAGE(PG8_SA(0, 1), a2 + hstep, voffA);
            PG8_WAIT_V(8); PG8_WAIT_L(0); PG8_BAR; PG8_MMA(0, 0, At, B0); PG8_MMA(0, 1, At, B1); PG8_BAR; PG8_SCHED;
            PG8_LDA(At, 1, 1); PG8_STAGE(PG8_SB(1, 0), b3, voffB); PG8_STAGE(PG8_SB(1, 1), b3 + hstep, voffB); PG8_STAGE(PG8_SA(1, 0), a3, voffA);
            PG8_WAIT_V(8); PG8_WAIT_L(0); PG8_BAR; PG8_MMA(1, 0, At, B0); PG8_MMA(1, 1, At, B1); PG8_BAR; PG8_SCHED;
        }
        if (wr == 0) PG8_BAR;
        E(acc, cur, wr, wc, fr, fq);
        if (!has_next) break;
#pragma unroll
        for (int a = 0; a < 2; ++a)
#pragma unroll
            for (int b = 0; b < 2; ++b)
#pragma unroll
                for (int m = 0; m < 4; ++m)
#pragma unroll
                    for (int n = 0; n < 2; ++n) acc[a][b][m][n] = (f32x4){0.f, 0.f, 0.f, 0.f};
        cur = nxt; cA = nA; cB = nB; ++ui;
        if (wr == 1) PG8_BAR;
    }
    PG8_WAIT_V(0);
    PG8_BAR;
#undef PG8_SA
#undef PG8_SB
#undef PG8_STAGE
#undef PG8_LDA
#undef PG8_LDB
#undef PG8_MMA
#undef PG8_WAIT_V
#undef PG8_WAIT_L
#undef PG8_BAR
#undef PG8_SCHED
}
}

#define XB_TMO      128
#define XB_XCNT(j)  (256  + 64 * (j))
#define XB_XSUB(j)  (1280 + 64 * (j))
#define XB_XGEN(j)  (2304 + 64 * (j))
#define XB_TOP      3328
#define XB_TOPGEN   3392
#define XCD_BAR_WORDS 3456
#define XB_SPIN_CAP (1u << 18)

__device__ __forceinline__ unsigned xb_ld(unsigned* p)              { return __hip_atomic_load(p, __ATOMIC_RELAXED, __HIP_MEMORY_SCOPE_AGENT); }
__device__ __forceinline__ unsigned xb_add(unsigned* p, unsigned v) { return __hip_atomic_fetch_add(p, v, __ATOMIC_RELAXED, __HIP_MEMORY_SCOPE_AGENT); }
__device__ __forceinline__ unsigned xb_xcc_id() { return (unsigned)__builtin_amdgcn_s_getreg((3 << 11) | 20) & 0xFu; }
#define XB_SPIN(cond, bar) do { unsigned _sp = 0; while (cond) { __builtin_amdgcn_s_sleep(1); \
    if ((++_sp & 255u) == 0u) { if (xb_ld(&(bar)[XB_TMO])) break; if (_sp > XB_SPIN_CAP) { atomicAdd(&(bar)[XB_TMO], 1u); break; } } } } while (0)

struct XcdBarrier {
    unsigned* bar; unsigned x;
    volatile LAS unsigned* st;
};

__device__ __forceinline__ XcdBarrier xcd_barrier_post(unsigned* bar, volatile LAS unsigned* st) {
    XcdBarrier b; b.bar = bar; b.x = xb_xcc_id(); b.st = st;
    if (threadIdx.x == 0) (void)xb_add(&bar[XB_XCNT(b.x)], 1u);
    return b;
}
__device__ __forceinline__ void xcd_barrier_complete(unsigned* bar, unsigned x, unsigned& nloc, unsigned& nx) {
    const unsigned G = gridDim.x * gridDim.y * gridDim.z;
    unsigned sum, cnt, mine, sp = 0u;
    for (;;) {
        sum = 0u; cnt = 0u; mine = 0u;
#pragma unroll
        for (unsigned j = 0; j < 16; ++j) { const unsigned c = xb_ld(&bar[XB_XCNT(j)]); sum += c; cnt += (c > 0u) ? 1u : 0u; mine = (j == x) ? c : mine; }
        if (sum == G) break;
        __builtin_amdgcn_s_sleep(1);
        if ((++sp & 255u) == 0u) { if (xb_ld(&bar[XB_TMO])) break; if (sp > XB_SPIN_CAP) { atomicAdd(&bar[XB_TMO], 1u); break; } }
    }
    nloc = mine > 0u ? mine : 1u; nx = cnt > 0u ? cnt : 1u;
}

__device__ __forceinline__ void xcd_barrier(const XcdBarrier& b) {
    asm volatile("s_waitcnt vmcnt(0)" ::: "memory");
    __syncthreads();
    if (threadIdx.x == 0) {
        unsigned* bar = b.bar;
        __builtin_amdgcn_s_waitcnt(0);
        unsigned nloc = b.st[0], nx = b.st[1];
        if (nloc == 0u) { xcd_barrier_complete(bar, b.x, nloc, nx); b.st[0] = nloc; b.st[1] = nx; }
        const unsigned old = xb_add(&bar[XB_XSUB(b.x)], 1u);
        const unsigned gen = old / nloc;
        if (old + 1u == (gen + 1u) * nloc) {
            __builtin_amdgcn_fence(__ATOMIC_RELEASE, "agent");
            asm volatile("s_waitcnt vmcnt(0)" ::: "memory");
            const unsigned og = xb_add(&bar[XB_TOP], 1u);
            const unsigned tg = og / nx;
            if (og + 1u == (tg + 1u) * nx) xb_add(&bar[XB_TOPGEN], 1u);
            else XB_SPIN(xb_ld(&bar[XB_TOPGEN]) == tg, bar);
            __builtin_amdgcn_fence(__ATOMIC_ACQUIRE, "agent");
            xb_add(&bar[XB_XGEN(b.x)], 1u);
            asm volatile("s_waitcnt vmcnt(0)" ::: "memory");
        } else {
            XB_SPIN(xb_ld(&bar[XB_XGEN(b.x)]) == gen, bar);
            __builtin_amdgcn_fence(__ATOMIC_ACQUIRE, "agent");
            asm volatile("s_waitcnt vmcnt(0)" ::: "memory");
        }
    }
    __syncthreads();
}


__device__ __forceinline__ float wave_sum(float v) {
#pragma unroll
    for (int o = 1; o < 64; o <<= 1) v += __shfl_xor(v, o);
    return v;
}
__device__ __forceinline__ unsigned pk2(float lo, float hi) { return pg8::cvt_pk_bf16(lo, hi); }
__device__ __forceinline__ int rel_bucket(int rel) {
    const int n = rel < 0 ? -rel : rel;
    const int v = n < 8 ? n : 8 + (n >= 15) + (n >= 27) + (n >= 50) + (n >= 91) + (n >= 166) + (n >= 305) + (n >= 559);
    return (rel > 0 ? 16 : 0) + v;
}

__device__ __forceinline__ void transpose_item(const float* W, int K, int N, const float* gain, bf16_t* WT, int mode, LAS float* scr, int item, int lane) {
    const int nblk = N / 32, kb = item / nblk, nb = item % nblk, k0 = 64 * kb, n0 = 32 * nb;
#pragma unroll 8
    for (int i = 0; i < 32; ++i) { const int kk = 2 * i + (lane >> 5); float w = W[(size_t)(k0 + kk) * N + n0 + (lane & 31)]; if (gain) w *= gain[k0 + kk]; scr[kk * 33 + (lane & 31)] = w; }
    asm volatile("s_waitcnt lgkmcnt(0)" ::: "memory");
    const int c = lane & 7;
    const int d0 = (mode == 0) ? n0 : ((n0 >> 7) * 256 + (n0 & 127) + (mode == 2 ? 128 : 0));
#pragma unroll
    for (int j = 0; j < 4; ++j) { const int n = (lane >> 3) + 8 * j; const LAS float* s = scr + (8 * c) * 33 + n;
        u32x4 o; o.x = pk2(s[0 * 33], s[1 * 33]); o.y = pk2(s[2 * 33], s[3 * 33]); o.z = pk2(s[4 * 33], s[5 * 33]); o.w = pk2(s[6 * 33], s[7 * 33]);
        *(u32x4*)(WT + (size_t)(d0 + n) * K + k0 + 8 * c) = o; }
    asm volatile("s_waitcnt lgkmcnt(0)" ::: "memory");
}

constexpr int ATT_V_OFF = 36864, ATT_TB_OFF = 73728, ATT_TB_N = 384, ATT_TB_VAR = 4 * ATT_TB_N;
struct AttUnit { size_t tok0; int sh, q0, c_lo, c_hi, br, hsel; };
template <bool DIL>
__device__ __forceinline__ AttUnit att_decode(int u) {
    AttUnit p;
    if (DIL) {
        const int blk = (u >> 1) & 63, rest = u >> 7; p.hsel = u & 1; p.br = rest % 3; const int b = rest / 3; p.sh = 2 * p.br;
        const int nb = 64 >> p.sh, rho = blk >> (6 - p.sh); p.q0 = 64 * (blk & (nb - 1));
        p.tok0 = (size_t)b * SEQ + rho;
        const int Ls = SEQ >> p.sh; p.c_lo = (p.q0 == 0) ? 1 : 0; p.c_hi = (p.q0 + 64 >= Ls) ? 1 : 2;
    } else {
        p.hsel = u & 1; const int tile = (u >> 1) & 63, b = u >> 7; p.q0 = 64 * tile; p.br = 0; p.sh = 0; p.tok0 = (size_t)b * SEQ;
        p.c_lo = (p.q0 >= 128) ? 0 : (p.q0 >= 64 ? 1 : 2); p.c_hi = (p.q0 + 192 <= SEQ) ? 4 : (p.q0 + 128 <= SEQ ? 3 : 2);
    }
    return p;
}
__device__ __forceinline__ void att_fill_table(LAS float* tb, const float* rel, int variant, int hsel, int tid) {
    const int win = variant == 0 ? 128 : 64, d = variant == 0 ? 1 : (1 << (2 * (variant - 1))), bhead = variant == 0 ? 8 + 4 * hsel : 4 * hsel;
    for (int e = tid; e < ATT_TB_VAR; e += 512) {
        const int hh = e / ATT_TB_N, idx = e % ATT_TB_N, delta = idx - 191;
        float v = -1e30f;
        if (delta >= -win && delta <= win) v = rel[rel_bucket(delta * d) * 16 + bhead + hh] * LOG2E;
        tb[variant * ATT_TB_VAR + e] = v;
    }
}
template <bool DIL>
__device__ __forceinline__ void attn_stream(LAS unsigned char* lds, const int tid, const bf16_t* proj, const float* rel, const float* sink, bf16_t* obuf, unsigned char* ws,
                                            int i, const int i_end, const int G, const int ubase) {
    if (i >= i_end) return;
    constexpr int PPK = DIL ? 32 : 8, NIT = DIL ? 4 : 1, KS = DIL ? 528 : 144, VS = DIL ? 576 : 192, KFIRST = DIL ? -64 : -128;
    const int lane = tid & 63, wid = __builtin_amdgcn_readfirstlane(tid >> 6);
    const int hl = wid >> 1, qh = wid & 1, r = lane & 31, h = lane >> 5;
    LAS float* tb = (LAS float*)(lds + ATT_TB_OFF);
    AttUnit cur = att_decode<DIL>(i - ubase), nxt = cur;
    int hsel = cur.hsel;
    __syncthreads();
    if (DIL) { att_fill_table(tb, rel, 1, hsel, tid); att_fill_table(tb, rel, 2, hsel, tid); att_fill_table(tb, rel, 3, hsel, tid); } else att_fill_table(tb, rel, 0, hsel, tid);
    const int hlk = DIL ? hl : 0;
    const LAS unsigned char* kread = lds + r * KS + hlk * 128 + 16 * h;
    const LAS unsigned char* vread = lds + ATT_V_OFF + (4 * h + ((lane & 15) >> 2)) * VS + (hlk * 64 + 16 * ((lane >> 4) & 1) + 4 * (lane & 3)) * 2;
    u32x4 kreg[NIT], vreg[NIT];
    bf16x8 qf[4], qn[4];
#define ATT_COLS(P) const int qcol = DIL ? (P).hsel * 256 : 1536 + (P).hsel * 256, kcol = DIL ? 512 + (P).hsel * 256 : 2048 + (P).hsel * 64, vcol = DIL ? 1024 + (P).hsel * 256 : 2176 + (P).hsel * 64
#define ATT_PREFETCH(P, c) do { ATT_COLS(P); (void)qcol; const int ks0 = (P).q0 + KFIRST + 64 * (c); const bf16_t* kb_ = proj + (P).tok0 * NQKV; const size_t ts_ = (size_t)NQKV << (P).sh; \
        _Pragma("unroll") for (int it = 0; it < NIT; ++it) { const int p = tid + 512 * it, key = p / PPK, hc = p % PPK; \
        const bf16_t* src = kb_ + (size_t)(ks0 + key) * ts_ + hc * 8; kreg[it] = *(const u32x4*)(src + kcol); vreg[it] = *(const u32x4*)(src + vcol); } } while (0)
#define ATT_LOADQ(P, Q) do { ATT_COLS(P); (void)kcol; (void)vcol; const bf16_t* qrow = proj + ((P).tok0 + ((size_t)((P).q0 + 32 * qh + r) << (P).sh)) * NQKV + qcol + hl * 64 + 8 * h; \
        _Pragma("unroll") for (int s_ = 0; s_ < 4; ++s_) Q[s_] = *(const bf16x8*)(qrow + 16 * s_); } while (0)
    ATT_LOADQ(cur, qf);
    int c = cur.c_lo;
    ATT_PREFETCH(cur, c);
    float m_run, l_run; f32x16 o0, o1;
#define ATT_INIT(P) do { if (DIL) { m_run = -1e30f; l_run = 0.f; } else { m_run = sink[4 * (P).hsel + hl] * LOG2E; l_run = (h == 0) ? 1.0f : 0.0f; } \
        _Pragma("unroll") for (int i_ = 0; i_ < 16; ++i_) { o0[i_] = 0.f; o1[i_] = 0.f; } } while (0)
    ATT_INIT(cur);
    for (;;) {
        __syncthreads();
#pragma unroll
        for (int it = 0; it < NIT; ++it) { const int p = tid + 512 * it, key = p / PPK, hc = p % PPK;
            *(LAS u32x4*)(lds + key * KS + hc * 16) = kreg[it]; *(LAS u32x4*)(lds + ATT_V_OFF + key * VS + hc * 16) = vreg[it]; }
        __syncthreads();
        const bool last_chunk = (c == cur.c_hi), has_next = (i + G < i_end);
        if (!last_chunk) ATT_PREFETCH(cur, c + 1);
        else if (has_next) { nxt = att_decode<DIL>(i + G - ubase); ATT_PREFETCH(nxt, nxt.c_lo); ATT_LOADQ(nxt, qn); }
        f32x16 x0, x1;
        const LAS float* tbp = tb + (DIL ? 1 + cur.br : 0) * ATT_TB_VAR + hl * ATT_TB_N + (KFIRST + 64 * c + 191 + 4 * h - 32 * qh - r);
#pragma unroll
        for (int i_ = 0; i_ < 16; ++i_) { const int ko = (i_ & 3) + 8 * (i_ >> 2); x0[i_] = tbp[ko]; x1[i_] = tbp[32 + ko]; }
#pragma unroll
        for (int s = 0; s < 4; ++s) {
            const bf16x8 a0 = *(const LAS bf16x8*)(kread + s * 32), a1 = *(const LAS bf16x8*)(kread + 32 * KS + s * 32);
            x0 = __builtin_amdgcn_mfma_f32_32x32x16_bf16(a0, qf[s], x0, 0, 0, 0);
            x1 = __builtin_amdgcn_mfma_f32_32x32x16_bf16(a1, qf[s], x1, 0, 0, 0);
        }
        float mx = -1e30f;
#pragma unroll
        for (int i_ = 0; i_ < 16; ++i_) mx = fmaxf(mx, fmaxf(x0[i_], x1[i_]));
        mx = fmaxf(mx, __shfl_xor(mx, 32));
        const float m_new = fmaxf(m_run, mx), alpha = __builtin_amdgcn_exp2f(m_run - m_new); m_run = m_new;
        float rsum = 0.f;
#pragma unroll
        for (int i_ = 0; i_ < 16; ++i_) { x0[i_] = __builtin_amdgcn_exp2f(x0[i_] - m_new); x1[i_] = __builtin_amdgcn_exp2f(x1[i_] - m_new); rsum += x0[i_] + x1[i_]; }
        l_run = l_run * alpha + rsum;
#pragma unroll
        for (int i_ = 0; i_ < 16; ++i_) { o0[i_] *= alpha; o1[i_] *= alpha; }
#pragma unroll
        for (int kb = 0; kb < 2; ++kb)
#pragma unroll
            for (int s = 0; s < 2; ++s) {
                u32x4 pw;
                if (kb == 0) { pw.x = pk2(x0[8 * s + 0], x0[8 * s + 1]); pw.y = pk2(x0[8 * s + 2], x0[8 * s + 3]); pw.z = pk2(x0[8 * s + 4], x0[8 * s + 5]); pw.w = pk2(x0[8 * s + 6], x0[8 * s + 7]); }
                else         { pw.x = pk2(x1[8 * s + 0], x1[8 * s + 1]); pw.y = pk2(x1[8 * s + 2], x1[8 * s + 3]); pw.z = pk2(x1[8 * s + 4], x1[8 * s + 5]); pw.w = pk2(x1[8 * s + 6], x1[8 * s + 7]); }
                const bf16x8 pb = __builtin_bit_cast(bf16x8, pw);
                const LAS unsigned char* vp = vread + (32 * kb + 16 * s) * VS;
                const s16x4 lo0 = __builtin_bit_cast(s16x4, __builtin_amdgcn_ds_read_tr16_b64_v4i16((LAS s16x4*)(vp)));
                const s16x4 hi0 = __builtin_bit_cast(s16x4, __builtin_amdgcn_ds_read_tr16_b64_v4i16((LAS s16x4*)(vp + 8 * VS)));
                const s16x4 lo1 = __builtin_bit_cast(s16x4, __builtin_amdgcn_ds_read_tr16_b64_v4i16((LAS s16x4*)(vp + 64)));
                const s16x4 hi1 = __builtin_bit_cast(s16x4, __builtin_amdgcn_ds_read_tr16_b64_v4i16((LAS s16x4*)(vp + 64 + 8 * VS)));
                const bf16x8 va0 = (bf16x8){lo0[0], lo0[1], lo0[2], lo0[3], hi0[0], hi0[1], hi0[2], hi0[3]};
                const bf16x8 va1 = (bf16x8){lo1[0], lo1[1], lo1[2], lo1[3], hi1[0], hi1[1], hi1[2], hi1[3]};
                o0 = __builtin_amdgcn_mfma_f32_32x32x16_bf16(va0, pb, o0, 0, 0, 0);
                o1 = __builtin_amdgcn_mfma_f32_32x32x16_bf16(va1, pb, o1, 0, 0, 0);
            }
        if (!last_chunk) { ++c; continue; }
        {
            const float l_tot = l_run + __shfl_xor(l_run, 32);
            const float inv = 1.0f / l_tot;
            const size_t tok = cur.tok0 + ((size_t)(cur.q0 + 32 * qh + r) << cur.sh);
            bf16_t* op = DIL ? ((cur.br == 2) ? (bf16_t*)(ws + WS_OP2) : (bf16_t*)(ws + WS_XB + (size_t)cur.br * OP_BYTES)) : obuf;
            bf16_t* orow = op + tok * (DIL ? 512 : 1024) + (DIL ? cur.hsel * 256 : 512 + cur.hsel * 256) + hl * 64 + 4 * h;
#pragma unroll
            for (int g4 = 0; g4 < 4; ++g4) {
                u32x2 w0, w1;
                w0.x = pk2(o0[4 * g4 + 0] * inv, o0[4 * g4 + 1] * inv); w0.y = pk2(o0[4 * g4 + 2] * inv, o0[4 * g4 + 3] * inv);
                w1.x = pk2(o1[4 * g4 + 0] * inv, o1[4 * g4 + 1] * inv); w1.y = pk2(o1[4 * g4 + 2] * inv, o1[4 * g4 + 3] * inv);
                *(u32x2*)(orow + 8 * g4) = w0; *(u32x2*)(orow + 32 + 8 * g4) = w1;
            }
            if (DIL && h == 0) { float* lse = (float*)(ws + WS_LSE); lse[((size_t)cur.br * T + tok) * 8 + 4 * cur.hsel + hl] = m_run + __builtin_amdgcn_logf(l_tot); }
        }
        if (!has_next) break;
        i += G; cur = nxt; c = cur.c_lo;
#pragma unroll
        for (int s_ = 0; s_ < 4; ++s_) qf[s_] = qn[s_];
        ATT_INIT(cur);
        if (cur.hsel != hsel) {
            hsel = cur.hsel; __syncthreads();
            if (DIL) { att_fill_table(tb, rel, 1, hsel, tid); att_fill_table(tb, rel, 2, hsel, tid); att_fill_table(tb, rel, 3, hsel, tid); } else att_fill_table(tb, rel, 0, hsel, tid);
        }
    }
#undef ATT_COLS
#undef ATT_PREFETCH
#undef ATT_LOADQ
#undef ATT_INIT
}

struct Args { const float* in[16]; float* out; unsigned char* ws; int ph_lo, ph_hi, coop, pad; };
constexpr int LDS_BYTES = 147456;
constexpr int N_PHASES = 18;

__global__ void __launch_bounds__(512, 2) fwd_mega(Args args) {
    extern __shared__ __attribute__((aligned(16))) unsigned char lds_raw[];
    LAS unsigned char* lds = (LAS unsigned char*)lds_raw;
    cg::grid_group grid = cg::this_grid();
    const int ph_hi = args.ph_hi, coop = args.coop;
    if (threadIdx.x < 2) ((LAS unsigned*)(lds + LDS_BARST_OFF))[threadIdx.x] = 0u;
    __syncthreads();
    XcdBarrier xbar; xbar.bar = (unsigned*)(args.ws + WS_BAR); xbar.x = 0; xbar.st = (volatile LAS unsigned*)(lds + LDS_BARST_OFF);
    bool posted = false;
    for (int ph = args.ph_lo; ph < ph_hi; ++ph) {
        int tid = threadIdx.x; asm volatile("" : "+v"(tid));
        int bidx = blockIdx.x; asm volatile("" : "+s"(bidx));
        const __attribute__((address_space(4))) Args* ap = (const __attribute__((address_space(4))) Args*)__builtin_amdgcn_kernarg_segment_ptr(); asm volatile("" : "+s"(ap));
        const int lane = tid & 63, wave = __builtin_amdgcn_readfirstlane(tid >> 6);
        const int G = gridDim.x, gw = bidx * 8 + wave, NGW = G * 8;
        unsigned char* ws = ap->ws;
        float* ssb = (float*)(ws + WS_SS);
        bf16_t* XB = (bf16_t*)(ws + WS_XB); bf16_t* OB = (bf16_t*)(ws + WS_O); bf16_t* HB = (bf16_t*)(ws + WS_H);
        float* out = ap->out;
        if (ph == 0) {
            LAS float* scr = (LAS float*)(lds + wave * 16384);
            constexpr int I_GU = (DM / 64) * (FF / 32), I_DN = (FF / 64) * (DM / 32), I_IN = (DM / 64) * (NQKV / 32), I_WO = (DM / 64) * (DM / 32);
            constexpr int I_LAYER = 4 * I_GU + 2 * I_DN + I_IN + I_WO;
            for (int it = gw; it < 2 * I_LAYER; it += NGW) {
                const int l = it / I_LAYER; int rr = it % I_LAYER;
                unsigned char* wl = ws + WS_W + (size_t)l * WL_BYTES;
                if (rr < I_GU) { transpose_item(ap->in[4] + (size_t)l * DM * FF, DM, FF, ap->in[3] + l * DM, (bf16_t*)(wl + WL_W1A), 1, scr, rr, lane); continue; } rr -= I_GU;
                if (rr < I_GU) { transpose_item(ap->in[5] + (size_t)l * DM * FF, DM, FF, ap->in[3] + l * DM, (bf16_t*)(wl + WL_W1A), 2, scr, rr, lane); continue; } rr -= I_GU;
                if (rr < I_DN) { transpose_item(ap->in[6] + (size_t)l * FF * DM, FF, DM, nullptr, (bf16_t*)(wl + WL_W2A), 0, scr, rr, lane); continue; } rr -= I_DN;
                if (rr < I_GU) { transpose_item(ap->in[12] + (size_t)l * DM * FF, DM, FF, ap->in[11] + l * DM, (bf16_t*)(wl + WL_W1B), 1, scr, rr, lane); continue; } rr -= I_GU;
                if (rr < I_GU) { transpose_item(ap->in[13] + (size_t)l * DM * FF, DM, FF, ap->in[11] + l * DM, (bf16_t*)(wl + WL_W1B), 2, scr, rr, lane); continue; } rr -= I_GU;
                if (rr < I_DN) { transpose_item(ap->in[14] + (size_t)l * FF * DM, FF, DM, nullptr, (bf16_t*)(wl + WL_W2B), 0, scr, rr, lane); continue; } rr -= I_DN;
                if (rr < I_IN) { transpose_item(ap->in[8] + (size_t)l * DM * NQKV, DM, NQKV, ap->in[7] + l * DM, (bf16_t*)(wl + WL_WIN), 0, scr, rr, lane); continue; } rr -= I_IN;
                transpose_item(ap->in[9] + (size_t)l * DM * DM, DM, DM, nullptr, (bf16_t*)(wl + WL_WO), 0, scr, rr, lane);
            }
            for (int row = gw; row < T; row += NGW) {
                const float* src = (row >= TP) ? ap->in[1] + (size_t)(row - TP) * DM : ap->in[0] + (size_t)row * DM;
                const f32x4* xr = (const f32x4*)src + lane; f32x4 v[4]; float s = 0.f;
#pragma unroll
                for (int j = 0; j < 4; ++j) { v[j] = xr[64 * j]; s += (v[j][0] * v[j][0] + v[j][1] * v[j][1]) + (v[j][2] * v[j][2] + v[j][3] * v[j][3]); }
                s = wave_sum(s);
                u32x2* o8 = (u32x2*)(XB + (size_t)row * DM) + lane;
#pragma unroll
                for (int j = 0; j < 4; ++j) { u32x2 w; w.x = pk2(v[j][0], v[j][1]); w.y = pk2(v[j][2], v[j][3]); o8[64 * j] = w; }
                if (lane == 0) ssb[row] = s;
            }
            for (int i = bidx * 512 + tid; i < 6 * T; i += G * 512) ssb[T + i] = 0.f;
            if (bidx == 0) { unsigned* bw = (unsigned*)(ws + WS_BAR); for (int i = tid; i < XCD_BAR_WORDS; i += 512) bw[i] = 0u; }
        } else if (ph == N_PHASES - 1) {
            const float* ss = ssb + 6 * (size_t)T; const float* gf = ap->in[15];
            f32x4 gv[4];
#pragma unroll
            for (int j = 0; j < 4; ++j) gv[j] = ((const f32x4*)gf)[lane + 64 * j];
            for (int row = gw; row < T; row += NGW) {
                const float rs = __builtin_amdgcn_rsqf(ss[row] * (1.0f / 1024.0f) + EPS);
                f32x4* xr = (f32x4*)(out + (size_t)row * DM) + lane;
#pragma unroll
                for (int j = 0; j < 4; ++j) { f32x4 v = xr[64 * j]; v = v * rs * gv[j]; xr[64 * j] = v; }
            }
        } else {
            const int l = (ph - 1) >> 3, k = (ph - 1) & 7;
            unsigned char* wl = ws + WS_W + (size_t)l * WL_BYTES;
            if (k == 0 || k == 6) {
                const float* ss = ssb + (size_t)(3 * l + (k == 0 ? 0 : 2)) * T;
                pg8::Gemm g{XB, (const bf16_t*)(wl + (k == 0 ? WL_W1A : WL_W1B)), T, 2 * FF, DM};
                pg8::StaticOrder S; S.init(T, 2 * FF, G, bidx);
                pg8::EpiSwiGLU E{HB, ss};
                pg8::gemm_phase<pg8::EpiSwiGLU, pg8::StaticOrder>(lds, tid, g, S, E);
            } else if (k == 1 || k == 7 || k == 5) {
                const bool first = (l == 0 && k == 1);
                const float* sA = first ? ap->in[0] : out; const float* sB = first ? ap->in[1] : out + (size_t)TP * DM;
                float* ssn = ssb + (size_t)(3 * l + (k == 1 ? 1 : (k == 5 ? 2 : 3))) * T;
                if (k == 5) {
                    pg8::Gemm g{OB, (const bf16_t*)(wl + WL_WO), T, DM, DM};
                    pg8::StaticOrder S; S.init(T, DM, G, bidx);
                    pg8::EpiRes E{sA, sB, out, XB, ssn, 1.0f};
                    pg8::gemm_phase<pg8::EpiRes, pg8::StaticOrder>(lds, tid, g, S, E);
                } else {
                    pg8::Gemm g{HB, (const bf16_t*)(wl + (k == 1 ? WL_W2A : WL_W2B)), T, DM, FF};
                    pg8::StaticOrder S; S.init(T, DM, G, bidx);
                    pg8::EpiRes E{sA, sB, out, (l == 1 && k == 7) ? (bf16_t*)nullptr : XB, ssn, 0.5f};
                    pg8::gemm_phase<pg8::EpiRes, pg8::StaticOrder>(lds, tid, g, S, E);
                }
            } else if (k == 2) {
                const float* ss = ssb + (size_t)(3 * l + 1) * T;
                pg8::Gemm g{XB, (const bf16_t*)(wl + WL_WIN), T, NQKV, DM};
                pg8::StaticOrder S; S.init(T, NQKV, G, bidx);
                pg8::EpiQKV E{HB, ss};
                pg8::gemm_phase<pg8::EpiQKV, pg8::StaticOrder>(lds, tid, g, S, E);
            } else if (k == 3) {
                const float* rel = ap->in[2]; const float* sink = ap->in[10] + l * 8;
                {
                    const int vcu = (G % 8 == 0) ? (bidx % 8) * (G / 8) + bidx / 8 : bidx;
                    int iB = vcu, iD = vcu;
                    while (iD < 2560) iD += G;
                    attn_stream<false>(lds, tid, HB, rel, sink, OB, ws, iB, 2560, G, 0);
                    attn_stream<true>(lds, tid, HB, rel, sink, OB, ws, iD, 2560 + 7680, G, 2560);
                }
                __syncthreads();
            } else {
                const float* lse = (const float*)(ws + WS_LSE);
                const bf16_t* p0 = (const bf16_t*)(ws + WS_XB); const bf16_t* p1 = (const bf16_t*)(ws + WS_XB + OP_BYTES); const bf16_t* p2 = (const bf16_t*)(ws + WS_OP2);
                for (size_t idx = (size_t)bidx * 512 + tid; idx < (size_t)T * 32; idx += (size_t)G * 512) {
                    const size_t tok = idx >> 5; const int hd = (int)(idx >> 2) & 7, c16 = (int)idx & 3;
                    const float l0 = lse[tok * 8 + hd], l1 = lse[((size_t)T + tok) * 8 + hd], l2 = lse[((size_t)2 * T + tok) * 8 + hd];
                    const size_t off = tok * 512 + hd * 64 + c16 * 16;
                    u32x4 a[2], bq[2], cq[2];
#pragma unroll
                    for (int e = 0; e < 2; ++e) { a[e] = *(const u32x4*)(p0 + off + 8 * e); bq[e] = *(const u32x4*)(p1 + off + 8 * e); cq[e] = *(const u32x4*)(p2 + off + 8 * e); }
                    const float mx = fmaxf(l0, fmaxf(l1, l2));
                    float w0 = __builtin_amdgcn_exp2f(l0 - mx), w1 = __builtin_amdgcn_exp2f(l1 - mx), w2 = __builtin_amdgcn_exp2f(l2 - mx);
                    const float inv = 1.0f / (w0 + w1 + w2); w0 *= inv; w1 *= inv; w2 *= inv;
#pragma unroll
                    for (int e = 0; e < 2; ++e) {
                        u32x4 o;
#pragma unroll
                        for (int j = 0; j < 4; ++j) {
                            const float a_lo = __uint_as_float(a[e][j] << 16), a_hi = __uint_as_float(a[e][j] & 0xffff0000u);
                            const float b_lo = __uint_as_float(bq[e][j] << 16), b_hi = __uint_as_float(bq[e][j] & 0xffff0000u);
                            const float c_lo = __uint_as_float(cq[e][j] << 16), c_hi = __uint_as_float(cq[e][j] & 0xffff0000u);
                            o[j] = pk2(w0 * a_lo + w1 * b_lo + w2 * c_lo, w0 * a_hi + w1 * b_hi + w2 * c_hi);
                        }
                        *(u32x4*)(OB + tok * 1024 + hd * 64 + c16 * 16 + 8 * e) = o;
                    }
                }
            }
        }
        if (ph + 1 < ph_hi && coop) {
            if (!posted) { grid.sync(); xbar = xcd_barrier_post((unsigned*)(args.ws + WS_BAR), (volatile LAS unsigned*)(lds + LDS_BARST_OFF)); posted = true; }
            else xcd_barrier(xbar);
        }
    }
}

extern "C" void kernel_launch(void* const* d_in, const int* in_sizes, int n_in, void* d_out, int out_size, void* d_ws, size_t ws_size, hipStream_t stream) {
    static int grid = 0;
    if (grid == 0) {
        if (n_in != 16 || out_size != T * DM || ws_size < WS_END) { fprintf(stderr, "kernel_launch: unexpected shapes (n_in %d out %d ws %zu)\n", n_in, out_size, ws_size); grid = -1; return; }
        int dev = 0, cus = 0, per_cu = 0;
        hipGetDevice(&dev); hipDeviceGetAttribute(&cus, hipDeviceAttributeMultiprocessorCount, dev);
        if (hipFuncSetAttribute((const void*)fwd_mega, hipFuncAttributeMaxDynamicSharedMemorySize, LDS_BYTES) != hipSuccess) { fprintf(stderr, "kernel_launch: hipFuncSetAttribute failed\n"); grid = -1; return; }
        if (hipOccupancyMaxActiveBlocksPerMultiprocessor(&per_cu, (const void*)fwd_mega, 512, LDS_BYTES) != hipSuccess || per_cu < 1) per_cu = 1;
        (void)hipGetLastError();
        grid = cus * per_cu;
    }
    if (grid < 0) return;
    Args a{};
    for (int i = 0; i < 16; ++i) a.in[i] = (const float*)d_in[i];
    a.out = (float*)d_out; a.ws = (unsigned char*)d_ws;
#if MK_PER_PHASE
    for (int ph = 0; ph < N_PHASES; ++ph) {
        a.ph_lo = ph; a.ph_hi = ph + 1; a.coop = 0;
        hipLaunchKernelGGL(fwd_mega, dim3(grid), dim3(512), LDS_BYTES, stream, a);
    }
#else
    a.ph_lo = 0; a.ph_hi = N_PHASES; a.coop = 1;
    void* kargs[] = {&a};
    hipError_t e = hipLaunchCooperativeKernel((const void*)fwd_mega, dim3(grid), dim3(512), kargs, LDS_BYTES, stream);
    if (e != hipSuccess) fprintf(stderr, "cooperative launch failed: %s (grid %d)\n", hipGetErrorString(e), grid);
#endif
}
```

```cpp
#include <hip/hip_runtime.h>
#include <hip/hip_cooperative_groups.h>
#include <cstdio>
#include <cstdint>
namespace cg = cooperative_groups;

#ifndef MK_PER_PHASE
#define MK_PER_PHASE 0
#endif

#ifndef SKEW1_TICKS
#define SKEW1_TICKS 0
#endif
#define LAS __attribute__((address_space(3)))
typedef unsigned short bf16_t;
typedef short bf16x8 __attribute__((ext_vector_type(8)));
typedef float f32x4 __attribute__((ext_vector_type(4)));
typedef float f32x16 __attribute__((ext_vector_type(16)));
typedef unsigned u32x4 __attribute__((ext_vector_type(4)));
typedef unsigned u32x2 __attribute__((ext_vector_type(2)));
typedef short s16x4 __attribute__((ext_vector_type(4)));

constexpr int T = 81920, TP = 65536, DM = 1024, FF = 2816, NQKV = 2304, SEQ = 4096, NSEQ = 20;
constexpr float EPS = 1e-6f, LOG2E = 1.4426950408889634f;
constexpr float QSCALE = 0.125f * LOG2E;

constexpr size_t MiB = 1u << 20;
constexpr size_t WS_SS = 1 * MiB;
constexpr size_t WS_LSE = 4 * MiB;
constexpr size_t WS_W = 12 * MiB;
constexpr size_t W1_BYTES = (size_t)2 * FF * DM * 2, W2_BYTES = (size_t)DM * FF * 2, WIN_BYTES = (size_t)NQKV * DM * 2, WO_BYTES = (size_t)DM * DM * 2;
constexpr size_t WL_W1A = 0, WL_W2A = WL_W1A + W1_BYTES, WL_WIN = WL_W2A + W2_BYTES, WL_WO = WL_WIN + WIN_BYTES, WL_W1B = WL_WO + WO_BYTES, WL_W2B = WL_W1B + W1_BYTES, WL_BYTES = WL_W2B + W2_BYTES;
constexpr size_t WS_XB = 92 * MiB;
constexpr size_t WS_O = 252 * MiB;
constexpr size_t WS_H = 412 * MiB;
constexpr size_t WS_OP2 = 772 * MiB;
constexpr size_t WS_XL = 852 * MiB;
constexpr size_t WS_BAR = 1012 * MiB;
constexpr size_t WS_END = 1013 * MiB;
constexpr int LDS_BARST_OFF = 131072 + 512;
static_assert(WS_W + 2 * WL_BYTES <= WS_XB, "weights fit");
constexpr size_t OP_BYTES = (size_t)T * 512 * 2;

namespace pg8 {
constexpr int BM = 256, BK = 64, HALF = 128, HTB = HALF * BK * 2, STAGE_BYTES = 8 * HTB, NXCD = 8, WGM = 8;
__host__ __device__ __forceinline__ int lds_byte(int r, int c) { const int st = (r >> 4) * 2 + (c >> 5), rr = r & 15, cc = c & 31, ob = rr * 64 + cc * 2; return st * 1024 + (ob ^ (((ob >> 9) & 1) << 5)); }
__host__ __device__ __forceinline__ void stage_rc(int b, int& R, int& C) { const int st = b / 1024, sb = b % 1024, swz = sb ^ (((sb >> 9) & 1) << 5); R = (st >> 1) * 16 + swz / 64; C = (st & 1) * 32 + (swz % 64) / 2; }
__host__ __device__ __forceinline__ int perm32(int rho) { const int n = rho >> 4, i = rho & 15; return 8 * (i >> 2) + 4 * n + (i & 3); }
struct Unit { int pm, pn; };
struct Gemm { const bf16_t* A; const bf16_t* Bt; int M, N, K; };
struct StaticOrder {
    int nM, nN, nwg, G, c, rev;
    __device__ void init(int M, int N, int G_, int c_, int rev_) { nM = M / BM; nN = N / BM; nwg = nM * nN; G = G_; c = c_; rev = rev_; }
    __device__ bool next(int i, Unit& u) const {
        const long L = (long)i * G + c; if (L >= nwg) return false;
        int wgid = (int)L; { const int q = nwg / NXCD, r = nwg % NXCD, xcd = wgid % NXCD, off = wgid / NXCD; wgid = (xcd < r ? xcd * (q + 1) : r * (q + 1) + (xcd - r) * q) + off; }
        const int nig = WGM * nN, gid = wgid / nig, fm = gid * WGM, gsz = (nM - fm) < WGM ? (nM - fm) : WGM;
        u.pm = fm + ((wgid % nig) % gsz); u.pn = (wgid % nig) / gsz; if (rev) u.pm = nM - 1 - u.pm; return true;
    }
};
__device__ __forceinline__ unsigned cvt_pk_bf16(float lo, float hi) { unsigned r; asm volatile("v_cvt_pk_bf16_f32 %0, %1, %2" : "=v"(r) : "v"(lo), "v"(hi)); return r; }

struct EpiSwiGLU {
    static constexpr bool PERM = true;
    bf16_t* H; const float* ss;
    __device__ __forceinline__ void operator()(const f32x4 (&acc)[2][2][4][2], const Unit& u, int wr, int wc, int fr, int fq) const {
        const int row0 = u.pm * BM + wr * 64 + fr; const int col0 = u.pn * 128 + wc * 32 + 8 * fq;
#pragma unroll
        for (int ai = 0; ai < 2; ++ai)
#pragma unroll
            for (int m = 0; m < 4; ++m) {
                const int row = row0 + ai * HALF + m * 16;
                const float rs = __builtin_amdgcn_rsqf(ss[row] * (1.0f / 1024.0f) + EPS);
                const float rsn = -rs * LOG2E, rs2 = rs * rs;
                typedef float f32x2 __attribute__((ext_vector_type(2)));
                unsigned hw[4];
#pragma unroll
                for (int n = 0; n < 2; ++n)
#pragma unroll
                    for (int jp = 0; jp < 2; ++jp) {
                        const f32x2 a = (f32x2){acc[ai][0][m][n][2 * jp], acc[ai][0][m][n][2 * jp + 1]}, b = (f32x2){acc[ai][1][m][n][2 * jp], acc[ai][1][m][n][2 * jp + 1]};
                        const f32x2 t = a * rsn;
                        f32x2 e; e.x = __builtin_amdgcn_exp2f(t.x); e.y = __builtin_amdgcn_exp2f(t.y);
                        const f32x2 d = e + 1.0f;
                        f32x2 r; r.x = __builtin_amdgcn_rcpf(d.x); r.y = __builtin_amdgcn_rcpf(d.y);
                        const f32x2 hh = (a * b) * (r * rs2);
                        hw[n * 2 + jp] = cvt_pk_bf16(hh.x, hh.y);
                    }
                u32x4 w; w.x = hw[0]; w.y = hw[1]; w.z = hw[2]; w.w = hw[3];
                *(u32x4*)(H + (size_t)row * FF + col0) = w;
            }
    }
};
struct EpiQKV {
    static constexpr bool PERM = true;
    bf16_t* P; const float* ss;
    __device__ __forceinline__ void operator()(const f32x4 (&acc)[2][2][4][2], const Unit& u, int wr, int wc, int fr, int fq) const {
        const int row0 = u.pm * BM + wr * 64 + fr; const int col0 = u.pn * BM + wc * 32 + 8 * fq;
        const float cs = (u.pn < 2 || u.pn == 6 || u.pn == 7) ? QSCALE : 1.0f;
#pragma unroll
        for (int ai = 0; ai < 2; ++ai)
#pragma unroll
            for (int m = 0; m < 4; ++m) {
                const int row = row0 + ai * HALF + m * 16;
                const float rs = __builtin_amdgcn_rsqf(ss[row] * (1.0f / 1024.0f) + EPS) * cs;
#pragma unroll
                for (int bj = 0; bj < 2; ++bj) {
                    const f32x4 v0 = acc[ai][bj][m][0] * rs, v1 = acc[ai][bj][m][1] * rs;
                    u32x4 w; w.x = cvt_pk_bf16(v0[0], v0[1]); w.y = cvt_pk_bf16(v0[2], v0[3]); w.z = cvt_pk_bf16(v1[0], v1[1]); w.w = cvt_pk_bf16(v1[2], v1[3]);
                    *(u32x4*)(P + (size_t)row * NQKV + col0 + bj * HALF) = w;
                }
            }
    }
};
struct EpiRes {
    static constexpr bool PERM = true;
    const float* srcA; const float* srcB; bf16_t* xh; bf16_t* xl; float* outf; float* ssn; float alpha;
    __device__ __forceinline__ void operator()(const f32x4 (&acc)[2][2][4][2], const Unit& u, int wr, int wc, int fr, int fq) const {
        const int row0 = u.pm * BM + wr * 64 + fr; const int col0 = u.pn * BM + wc * 32 + 8 * fq;
        const float* srcbase = srcA ? ((u.pm * BM >= TP) ? srcB - (size_t)TP * DM : srcA) : nullptr;
#pragma unroll
        for (int am = 0; am < 4; ++am) {
            const int ai = am >> 1, m0 = (am & 1) * 2;
            f32x4 pre[2][2][2];
            if (srcbase) {
#pragma unroll
                for (int mm = 0; mm < 2; ++mm) { const float* src = srcbase + (size_t)(row0 + ai * HALF + (m0 + mm) * 16) * DM + col0;
#pragma unroll
                    for (int bj = 0; bj < 2; ++bj) { pre[mm][bj][0] = __builtin_nontemporal_load((const f32x4*)(src + bj * HALF)); pre[mm][bj][1] = __builtin_nontemporal_load((const f32x4*)(src + bj * HALF + 4)); } }
            } else {
                u32x4 rh[2][2], rl[2][2];
#pragma unroll
                for (int mm = 0; mm < 2; ++mm) { const size_t off = (size_t)(row0 + ai * HALF + (m0 + mm) * 16) * DM + col0;
#pragma unroll
                    for (int bj = 0; bj < 2; ++bj) { rh[mm][bj] = *(const u32x4*)(xh + off + bj * HALF); rl[mm][bj] = *(const u32x4*)(xl + off + bj * HALF); } }
#pragma unroll
                for (int mm = 0; mm < 2; ++mm)
#pragma unroll
                    for (int bj = 0; bj < 2; ++bj)
#pragma unroll
                        for (int j = 0; j < 4; ++j) {
                            const float e0 = __uint_as_float(rh[mm][bj][j] << 16) + __uint_as_float(rl[mm][bj][j] << 16);
                            const float e1 = __uint_as_float(rh[mm][bj][j] & 0xffff0000u) + __uint_as_float(rl[mm][bj][j] & 0xffff0000u);
                            pre[mm][bj][j >> 1][2 * (j & 1)] = e0; pre[mm][bj][j >> 1][2 * (j & 1) + 1] = e1;
                        }
            }
#pragma unroll
            for (int mm = 0; mm < 2; ++mm) {
                const int m = m0 + mm;
                const int row = row0 + ai * HALF + m * 16;
                const size_t off = (size_t)row * DM + col0;
                float s = 0.f;
#pragma unroll
                for (int bj = 0; bj < 2; ++bj) {
                    const f32x4 a = pre[mm][bj][0] + acc[ai][bj][m][0] * alpha, b = pre[mm][bj][1] + acc[ai][bj][m][1] * alpha;
                    s += (a[0] * a[0] + a[1] * a[1]) + (a[2] * a[2] + a[3] * a[3]) + (b[0] * b[0] + b[1] * b[1]) + (b[2] * b[2] + b[3] * b[3]);
                    if (outf) { __builtin_nontemporal_store(a, (f32x4*)(outf + off + bj * HALF)); __builtin_nontemporal_store(b, (f32x4*)(outf + off + bj * HALF + 4)); }
                    else {
                        u32x4 wh, wl;
                        wh.x = cvt_pk_bf16(a[0], a[1]); wh.y = cvt_pk_bf16(a[2], a[3]); wh.z = cvt_pk_bf16(b[0], b[1]); wh.w = cvt_pk_bf16(b[2], b[3]);
                        wl.x = cvt_pk_bf16(a[0] - __uint_as_float(wh.x << 16), a[1] - __uint_as_float(wh.x & 0xffff0000u));
                        wl.y = cvt_pk_bf16(a[2] - __uint_as_float(wh.y << 16), a[3] - __uint_as_float(wh.y & 0xffff0000u));
                        wl.z = cvt_pk_bf16(b[0] - __uint_as_float(wh.z << 16), b[1] - __uint_as_float(wh.z & 0xffff0000u));
                        wl.w = cvt_pk_bf16(b[2] - __uint_as_float(wh.w << 16), b[3] - __uint_as_float(wh.w & 0xffff0000u));
                        *(u32x4*)(xh + off + bj * HALF) = wh; *(u32x4*)(xl + off + bj * HALF) = wl;
                    }
                }
                s += __shfl_xor(s, 16); s += __shfl_xor(s, 32);
                if (fq == 0) atomicAdd(ssn + row, s);
            }
            asm volatile("" ::: "memory");
        }
    }
};

template <class Epi, class Sched>
__device__ __forceinline__ void gemm_phase(LAS unsigned char* lds, const int tid, const Gemm g, const Sched& S, const Epi& E) {
    const int wid = __builtin_amdgcn_readfirstlane(tid >> 6), lane = tid & 63, wr = wid >> 2, wc = wid & 3, fr = lane & 15, fq = lane >> 4;
    const int K = g.K, nt = K / BK;
    unsigned voffA[2], voffB[2];
#pragma unroll
    for (int i = 0; i < 2; ++i) { int R, C; stage_rc(tid * 16 + i * 8192, R, C); const int Rb = Epi::PERM ? ((R & ~31) + perm32(R & 31)) : R;
        voffA[i] = (unsigned)(R * K + C) * 2u; voffB[i] = (unsigned)(Rb * K + C) * 2u; }
    const size_t kstep = (size_t)(BK * 2);
    const size_t hstep = (size_t)HALF * K * 2;
    const size_t tstep = 2 * hstep;
    const unsigned ldsw = (unsigned)wid * 1024u;
    const int aoff = lds_byte(wr * 64 + fr, fq * 8), boff = lds_byte(wc * 32 + fr, fq * 8);
#define PG8_SA(b, h) (((b) * 2 + (h)) * HTB)
#define PG8_SB(b, h) ((4 + (b) * 2 + (h)) * HTB)
#define PG8_STAGE(bufoff, gbase, voff) do { _Pragma("unroll") for (int _i = 0; _i < 2; ++_i) \
        __builtin_amdgcn_global_load_lds((const unsigned*)((const char*)(gbase) + (voff)[_i]), (LAS unsigned*)(lds + (bufoff) + ldsw + _i * 8192), 16, 0, 0); } while (0)
#define PG8_LDA(dst, b, h) do { _Pragma("unroll") for (int m = 0; m < 4; ++m) _Pragma("unroll") for (int k = 0; k < 2; ++k) dst[m][k] = *(const LAS bf16x8*)(lds + PG8_SA(b, h) + aoff + m * 2048 + k * 1024); } while (0)
#define PG8_LDB(dst, b, h) do { _Pragma("unroll") for (int n = 0; n < 2; ++n) _Pragma("unroll") for (int k = 0; k < 2; ++k) dst[n][k] = *(const LAS bf16x8*)(lds + PG8_SB(b, h) + boff + n * 2048 + k * 1024); } while (0)
#define PG8_MMA(ai, bj, At, Bt) do { __builtin_amdgcn_s_setprio(1); _Pragma("unroll") for (int m = 0; m < 4; ++m) _Pragma("unroll") for (int n = 0; n < 2; ++n) _Pragma("unroll") for (int k = 0; k < 2; ++k) \
        acc[ai][bj][m][n] = __builtin_amdgcn_mfma_f32_16x16x32_bf16(Bt[n][k], At[m][k], acc[ai][bj][m][n], 0, 0, 0); __builtin_amdgcn_s_setprio(0); } while (0)
#define PG8_WAIT_V(n) asm volatile("s_waitcnt vmcnt(" #n ")" ::: "memory")
#define PG8_WAIT_L(n) asm volatile("s_waitcnt lgkmcnt(" #n ")" ::: "memory")
#define PG8_BAR __builtin_amdgcn_s_barrier()
#define PG8_SCHED __builtin_amdgcn_sched_barrier(0)
    Unit cur, nxt; int ui = 0;
    if (!S.next(0, cur)) return;
    f32x4 acc[2][2][4][2];
#pragma unroll
    for (int a = 0; a < 2; ++a)
#pragma unroll
        for (int b = 0; b < 2; ++b)
#pragma unroll
            for (int m = 0; m < 4; ++m)
#pragma unroll
                for (int n = 0; n < 2; ++n) acc[a][b][m][n] = (f32x4){0.f, 0.f, 0.f, 0.f};
    bf16x8 At[4][2], B0[2][2], B1[2][2];
    const char* cA = (const char*)g.A + (size_t)cur.pm * tstep; const char* cB = (const char*)g.Bt + (size_t)cur.pn * tstep;
    PG8_STAGE(PG8_SB(0, 0), cB, voffB); PG8_STAGE(PG8_SB(0, 1), cB + hstep, voffB); PG8_STAGE(PG8_SA(0, 0), cA, voffA); PG8_STAGE(PG8_SA(0, 1), cA + hstep, voffA);
    if (wr == 1) PG8_BAR;
    PG8_WAIT_V(2); PG8_BAR;
    PG8_STAGE(PG8_SB(1, 0), cB + kstep, voffB); PG8_STAGE(PG8_SA(1, 0), cA + kstep, voffA); PG8_STAGE(PG8_SB(1, 1), cB + hstep + kstep, voffB);
    PG8_WAIT_V(6); PG8_BAR;
    for (;;) {
        const bool has_next = S.next(ui + 1, nxt);
        const char* nA = has_next ? (const char*)g.A + (size_t)nxt.pm * tstep : cA; const char* nB = has_next ? (const char*)g.Bt + (size_t)nxt.pn * tstep : cB;
        for (int t = 0; t < nt; t += 2) {
            const bool last = (t == nt - 2);
            const char* a1 = cA + (size_t)(t + 1) * kstep;
            const char* a2 = last ? nA : cA + (size_t)(t + 2) * kstep; const char* b2 = last ? nB : cB + (size_t)(t + 2) * kstep;
            const char* a3 = a2 + kstep; const char* b3 = b2 + kstep;
            PG8_LDB(B0, 0, 0); PG8_LDB(B1, 0, 1); PG8_SCHED; PG8_LDA(At, 0, 0); PG8_STAGE(PG8_SA(1, 1), a1 + hstep, voffA);
            PG8_WAIT_V(8); PG8_WAIT_L(0); PG8_BAR; PG8_MMA(0, 0, At, B0); PG8_MMA(0, 1, At, B1); PG8_BAR; PG8_SCHED;
            PG8_LDA(At, 0, 1); PG8_STAGE(PG8_SB(0, 0), b2, voffB); PG8_STAGE(PG8_SB(0, 1), b2 + hstep, voffB); PG8_STAGE(PG8_SA(0, 0), a2, voffA);
            PG8_WAIT_V(8); PG8_WAIT_L(0); PG8_BAR; PG8_MMA(1, 0, At, B0); PG8_MMA(1, 1, At, B1); PG8_BAR; PG8_SCHED;
            PG8_LDB(B0, 1, 0); PG8_LDB(B1, 1, 1); PG8_SCHED; PG8_LDA(At, 1, 0); PG8_STAGE(PG8_SA(0, 1), a2 + hstep, voffA);
            PG8_WAIT_V(8); PG8_WAIT_L(0); PG8_BAR; PG8_MMA(0, 0, At, B0); PG8_MMA(0, 1, At, B1); PG8_BAR; PG8_SCHED;
            PG8_LDA(At, 1, 1); PG8_STAGE(PG8_SB(1, 0), b3, voffB); PG8_STAGE(PG8_SB(1, 1), b3 + hstep, voffB); PG8_STAGE(PG8_SA(1, 0), a3, voffA);
            PG8_WAIT_V(8); PG8_WAIT_L(0); PG8_BAR; PG8_MMA(1, 0, At, B0); PG8_MMA(1, 1, At, B1); PG8_BAR; PG8_SCHED;
        }
        if (wr == 0) PG8_BAR;
        E(acc, cur, wr, wc, fr, fq);
        if (!has_next) break;
#pragma unroll
        for (int a = 0; a < 2; ++a)
#pragma unroll
            for (int b = 0; b < 2; ++b)
#pragma unroll
                for (int m = 0; m < 4; ++m)
#pragma unroll
                    for (int n = 0; n < 2; ++n) acc[a][b][m][n] = (f32x4){0.f, 0.f, 0.f, 0.f};
        cur = nxt; cA = nA; cB = nB; ++ui;
        if (wr == 1) PG8_BAR;
    }
    PG8_WAIT_V(0);
    PG8_BAR;
#undef PG8_SA
#undef PG8_SB
#undef PG8_STAGE
#undef PG8_LDA
#undef PG8_LDB
#undef PG8_MMA
#undef PG8_WAIT_V
#undef PG8_WAIT_L
#undef PG8_BAR
#undef PG8_SCHED
}
}

#define XB_TMO      128
#define XB_XCNT(j)  (256  + 64 * (j))
#define XB_XSUB(j)  (1280 + 64 * (j))
#define XB_XGEN(j)  (2304 + 64 * (j))
#define XB_TOP      3328
#define XB_TOPGEN   3392
#define XCD_BAR_WORDS 3456
#define XB_SPIN_CAP (1u << 18)

__device__ __forceinline__ unsigned xb_ld(unsigned* p)              { return __hip_atomic_load(p, __ATOMIC_RELAXED, __HIP_MEMORY_SCOPE_AGENT); }
__device__ __forceinline__ unsigned xb_add(unsigned* p, unsigned v) { return __hip_atomic_fetch_add(p, v, __ATOMIC_RELAXED, __HIP_MEMORY_SCOPE_AGENT); }
__device__ __forceinline__ unsigned xb_xcc_id() { return (unsigned)__builtin_amdgcn_s_getreg((3 << 11) | 20) & 0xFu; }
#define XB_SPIN(cond, bar) do { unsigned _sp = 0; while (cond) { __builtin_amdgcn_s_sleep(1); \
    if ((++_sp & 255u) == 0u) { if (xb_ld(&(bar)[XB_TMO])) break; if (_sp > XB_SPIN_CAP) { atomicAdd(&(bar)[XB_TMO], 1u); break; } } } } while (0)

struct XcdBarrier {
    unsigned* bar; unsigned x;
    volatile LAS unsigned* st;
};

__device__ __forceinline__ XcdBarrier xcd_barrier_post(unsigned* bar, volatile LAS unsigned* st) {
    XcdBarrier b; b.bar = bar; b.x = xb_xcc_id(); b.st = st;
    if (threadIdx.x == 0) (void)xb_add(&bar[XB_XCNT(b.x)], 1u);
    return b;
}
__device__ __forceinline__ void xcd_barrier_complete(unsigned* bar, unsigned x, unsigned& nloc, unsigned& nx) {
    const unsigned G = gridDim.x * gridDim.y * gridDim.z;
    unsigned sum, cnt, mine, sp = 0u;
    for (;;) {
        sum = 0u; cnt = 0u; mine = 0u;
#pragma unroll
        for (unsigned j = 0; j < 16; ++j) { const unsigned c = xb_ld(&bar[XB_XCNT(j)]); sum += c; cnt += (c > 0u) ? 1u : 0u; mine = (j == x) ? c : mine; }
        if (sum == G) break;
        __builtin_amdgcn_s_sleep(1);
        if ((++sp & 255u) == 0u) { if (xb_ld(&bar[XB_TMO])) break; if (sp > XB_SPIN_CAP) { atomicAdd(&bar[XB_TMO], 1u); break; } }
    }
    nloc = mine > 0u ? mine : 1u; nx = cnt > 0u ? cnt : 1u;
}

__device__ __forceinline__ void xcd_barrier(const XcdBarrier& b) {
    asm volatile("s_waitcnt vmcnt(0)" ::: "memory");
    __syncthreads();
    if (threadIdx.x == 0) {
        unsigned* bar = b.bar;
        __builtin_amdgcn_s_waitcnt(0);
        unsigned nloc = b.st[0], nx = b.st[1];
        if (nloc == 0u) { xcd_barrier_complete(bar, b.x, nloc, nx); b.st[0] = nloc; b.st[1] = nx; }
        const unsigned old = xb_add(&bar[XB_XSUB(b.x)], 1u);
        const unsigned gen = old / nloc;
        if (old + 1u == (gen + 1u) * nloc) {
            __builtin_amdgcn_fence(__ATOMIC_RELEASE, "agent");
            asm volatile("s_waitcnt vmcnt(0)" ::: "memory");
            const unsigned og = xb_add(&bar[XB_TOP], 1u);
            const unsigned tg = og / nx;
            if (og + 1u == (tg + 1u) * nx) xb_add(&bar[XB_TOPGEN], 1u);
            else XB_SPIN(xb_ld(&bar[XB_TOPGEN]) == tg, bar);
            __builtin_amdgcn_fence(__ATOMIC_ACQUIRE, "agent");
            xb_add(&bar[XB_XGEN(b.x)], 1u);
            asm volatile("s_waitcnt vmcnt(0)" ::: "memory");
        } else {
            XB_SPIN(xb_ld(&bar[XB_XGEN(b.x)]) == gen, bar);
            __builtin_amdgcn_fence(__ATOMIC_ACQUIRE, "agent");
            asm volatile("s_waitcnt vmcnt(0)" ::: "memory");
        }
    }
    __syncthreads();
}


__device__ __forceinline__ float wave_sum(float v) {
#pragma unroll
    for (int o = 1; o < 64; o <<= 1) v += __shfl_xor(v, o);
    return v;
}
__device__ __forceinline__ unsigned pk2(float lo, float hi) { return pg8::cvt_pk_bf16(lo, hi); }
__device__ __forceinline__ int rel_bucket(int rel) {
    const int n = rel < 0 ? -rel : rel;
    const int v = n < 8 ? n : 8 + (n >= 15) + (n >= 27) + (n >= 50) + (n >= 91) + (n >= 166) + (n >= 305) + (n >= 559);
    return (rel > 0 ? 16 : 0) + v;
}

__device__ __forceinline__ void transpose_item(const float* W, int K, int N, const float* gain, bf16_t* WT, int mode, LAS float* scr, int item, int lane) {
    const int nblk = N / 32, kb = item / nblk, nb = item % nblk, k0 = 64 * kb, n0 = 32 * nb;
#pragma unroll 8
    for (int i = 0; i < 32; ++i) { const int kk = 2 * i + (lane >> 5); float w = W[(size_t)(k0 + kk) * N + n0 + (lane & 31)]; if (gain) w *= gain[k0 + kk]; scr[kk * 33 + (lane & 31)] = w; }
    asm volatile("s_waitcnt lgkmcnt(0)" ::: "memory");
    const int c = lane & 7;
    const int d0 = (mode == 0) ? n0 : ((n0 >> 7) * 256 + (n0 & 127) + (mode == 2 ? 128 : 0));
#pragma unroll
    for (int j = 0; j < 4; ++j) { const int n = (lane >> 3) + 8 * j; const LAS float* s = scr + (8 * c) * 33 + n;
        u32x4 o; o.x = pk2(s[0 * 33], s[1 * 33]); o.y = pk2(s[2 * 33], s[3 * 33]); o.z = pk2(s[4 * 33], s[5 * 33]); o.w = pk2(s[6 * 33], s[7 * 33]);
        *(u32x4*)(WT + (size_t)(d0 + n) * K + k0 + 8 * c) = o; }
    asm volatile("s_waitcnt lgkmcnt(0)" ::: "memory");
}

constexpr int ATT_V_OFF = 36864, ATT_TB_OFF = 73728, ATT_TB_N = 384, ATT_TB_VAR = 4 * ATT_TB_N;
struct AttUnit { size_t tok0; int sh, q0, c_lo, c_hi, br, hsel; };
template <bool DIL>
__device__ __forceinline__ AttUnit att_decode(int u) {
    AttUnit p;
    if (DIL) {
        const int blk = (u >> 1) & 63, rest = u >> 7; p.hsel = u & 1; p.br = rest % 3; const int b = rest / 3; p.sh = 2 * p.br;
        const int nb = 64 >> p.sh, rho = blk >> (6 - p.sh); p.q0 = 64 * (blk & (nb - 1));
        p.tok0 = (size_t)b * SEQ + rho;
        const int Ls = SEQ >> p.sh; p.c_lo = (p.q0 == 0) ? 1 : 0; p.c_hi = (p.q0 + 64 >= Ls) ? 1 : 2;
    } else {
        p.hsel = u & 1; const int tile = (u >> 1) & 63, b = u >> 7; p.q0 = 64 * tile; p.br = 0; p.sh = 0; p.tok0 = (size_t)b * SEQ;
        p.c_lo = (p.q0 >= 128) ? 0 : (p.q0 >= 64 ? 1 : 2); p.c_hi = (p.q0 + 192 <= SEQ) ? 4 : (p.q0 + 128 <= SEQ ? 3 : 2);
    }
    return p;
}
__device__ __forceinline__ void att_fill_table(LAS float* tb, const float* rel, int variant, int hsel, int tid) {
    const int win = variant == 0 ? 128 : 64, d = variant == 0 ? 1 : (1 << (2 * (variant - 1))), bhead = variant == 0 ? 8 + 4 * hsel : 4 * hsel;
    for (int e = tid; e < ATT_TB_VAR; e += 512) {
        const int hh = e / ATT_TB_N, idx = e % ATT_TB_N, delta = idx - 191;
        float v = -1e30f;
        if (delta >= -win && delta <= win) v = rel[rel_bucket(delta * d) * 16 + bhead + hh] * LOG2E;
        tb[variant * ATT_TB_VAR + e] = v;
    }
}
template <bool DIL>
__device__ __forceinline__ void attn_stream(LAS unsigned char* lds, const int tid, const bf16_t* proj, const float* rel, const float* sink, bf16_t* obuf, unsigned char* ws, unsigned char* op01,
                                            int i, const int i_end, const int G, const int ubase) {
    if (i >= i_end) return;
    constexpr int PPK = DIL ? 32 : 8, NIT = DIL ? 4 : 1, KS = DIL ? 528 : 144, VS = DIL ? 576 : 192, KFIRST = DIL ? -64 : -128;
    const int lane = tid & 63, wid = __builtin_amdgcn_readfirstlane(tid >> 6);
    const int hl = wid >> 1, qh = wid & 1, r = lane & 31, h = lane >> 5;
    LAS float* tb = (LAS float*)(lds + ATT_TB_OFF);
    AttUnit cur = att_decode<DIL>(i - ubase), nxt = cur;
    int hsel = cur.hsel;
    __syncthreads();
    if (DIL) { att_fill_table(tb, rel, 1, hsel, tid); att_fill_table(tb, rel, 2, hsel, tid); att_fill_table(tb, rel, 3, hsel, tid); } else att_fill_table(tb, rel, 0, hsel, tid);
    const int hlk = DIL ? hl : 0;
    const LAS unsigned char* kread = lds + r * KS + hlk * 128 + 16 * h;
    const LAS unsigned char* vread = lds + ATT_V_OFF + (4 * h + ((lane & 15) >> 2)) * VS + (hlk * 64 + 16 * ((lane >> 4) & 1) + 4 * (lane & 3)) * 2;
    u32x4 kreg[NIT], vreg[NIT];
    bf16x8 qf[4], qn[4];
#define ATT_COLS(P) const int qcol = DIL ? (P).hsel * 256 : 1536 + (P).hsel * 256, kcol = DIL ? 512 + (P).hsel * 256 : 2048 + (P).hsel * 64, vcol = DIL ? 1024 + (P).hsel * 256 : 2176 + (P).hsel * 64
#define ATT_PREFETCH(P, c) do { ATT_COLS(P); (void)qcol; const int ks0 = (P).q0 + KFIRST + 64 * (c); const bf16_t* kb_ = proj + (P).tok0 * NQKV; const size_t ts_ = (size_t)NQKV << (P).sh; \
        _Pragma("unroll") for (int it = 0; it < NIT; ++it) { const int p = tid + 512 * it, key = p / PPK, hc = p % PPK; \
        const bf16_t* src = kb_ + (size_t)(ks0 + key) * ts_ + hc * 8; kreg[it] = *(const u32x4*)(src + kcol); vreg[it] = *(const u32x4*)(src + vcol); } } while (0)
#define ATT_LOADQ(P, Q) do { ATT_COLS(P); (void)kcol; (void)vcol; const bf16_t* qrow = proj + ((P).tok0 + ((size_t)((P).q0 + 32 * qh + r) << (P).sh)) * NQKV + qcol + hl * 64 + 8 * h; \
        _Pragma("unroll") for (int s_ = 0; s_ < 4; ++s_) Q[s_] = *(const bf16x8*)(qrow + 16 * s_); } while (0)
    ATT_LOADQ(cur, qf);
    int c = cur.c_lo;
    ATT_PREFETCH(cur, c);
    float m_run, l_run; f32x16 o0, o1;
#define ATT_INIT(P) do { if (DIL) { m_run = -1e30f; l_run = 0.f; } else { m_run = sink[4 * (P).hsel + hl] * LOG2E; l_run = (h == 0) ? 1.0f : 0.0f; } \
        _Pragma("unroll") for (int i_ = 0; i_ < 16; ++i_) { o0[i_] = 0.f; o1[i_] = 0.f; } } while (0)
    ATT_INIT(cur);
    for (;;) {
        __syncthreads();
#pragma unroll
        for (int it = 0; it < NIT; ++it) { const int p = tid + 512 * it, key = p / PPK, hc = p % PPK;
            *(LAS u32x4*)(lds + key * KS + hc * 16) = kreg[it]; *(LAS u32x4*)(lds + ATT_V_OFF + key * VS + hc * 16) = vreg[it]; }
        __syncthreads();
        const bool last_chunk = (c == cur.c_hi), has_next = (i + G < i_end);
        if (!last_chunk) ATT_PREFETCH(cur, c + 1);
        else if (has_next) { nxt = att_decode<DIL>(i + G - ubase); ATT_PREFETCH(nxt, nxt.c_lo); ATT_LOADQ(nxt, qn); }
        f32x16 x0, x1;
        const LAS float* tbp = tb + (DIL ? 1 + cur.br : 0) * ATT_TB_VAR + hl * ATT_TB_N + (KFIRST + 64 * c + 191 + 4 * h - 32 * qh - r);
#pragma unroll
        for (int i_ = 0; i_ < 16; ++i_) { const int ko = (i_ & 3) + 8 * (i_ >> 2); x0[i_] = tbp[ko]; x1[i_] = tbp[32 + ko]; }
#pragma unroll
        for (int s = 0; s < 4; ++s) {
            const bf16x8 a0 = *(const LAS bf16x8*)(kread + s * 32), a1 = *(const LAS bf16x8*)(kread + 32 * KS + s * 32);
            x0 = __builtin_amdgcn_mfma_f32_32x32x16_bf16(a0, qf[s], x0, 0, 0, 0);
            x1 = __builtin_amdgcn_mfma_f32_32x32x16_bf16(a1, qf[s], x1, 0, 0, 0);
        }
        float mx = -1e30f;
#pragma unroll
        for (int i_ = 0; i_ < 16; ++i_) mx = fmaxf(mx, fmaxf(x0[i_], x1[i_]));
        mx = fmaxf(mx, __shfl_xor(mx, 32));
        const float m_new = fmaxf(m_run, mx), alpha = __builtin_amdgcn_exp2f(m_run - m_new); m_run = m_new;
        float rsum = 0.f;
#pragma unroll
        for (int i_ = 0; i_ < 16; ++i_) { x0[i_] = __builtin_amdgcn_exp2f(x0[i_] - m_new); x1[i_] = __builtin_amdgcn_exp2f(x1[i_] - m_new); rsum += x0[i_] + x1[i_]; }
        l_run = l_run * alpha + rsum;
#pragma unroll
        for (int i_ = 0; i_ < 16; ++i_) { o0[i_] *= alpha; o1[i_] *= alpha; }
#pragma unroll
        for (int kb = 0; kb < 2; ++kb)
#pragma unroll
            for (int s = 0; s < 2; ++s) {
                u32x4 pw;
                if (kb == 0) { pw.x = pk2(x0[8 * s + 0], x0[8 * s + 1]); pw.y = pk2(x0[8 * s + 2], x0[8 * s + 3]); pw.z = pk2(x0[8 * s + 4], x0[8 * s + 5]); pw.w = pk2(x0[8 * s + 6], x0[8 * s + 7]); }
                else         { pw.x = pk2(x1[8 * s + 0], x1[8 * s + 1]); pw.y = pk2(x1[8 * s + 2], x1[8 * s + 3]); pw.z = pk2(x1[8 * s + 4], x1[8 * s + 5]); pw.w = pk2(x1[8 * s + 6], x1[8 * s + 7]); }
                const bf16x8 pb = __builtin_bit_cast(bf16x8, pw);
                const LAS unsigned char* vp = vread + (32 * kb + 16 * s) * VS;
                const s16x4 lo0 = __builtin_bit_cast(s16x4, __builtin_amdgcn_ds_read_tr16_b64_v4i16((LAS s16x4*)(vp)));
                const s16x4 hi0 = __builtin_bit_cast(s16x4, __builtin_amdgcn_ds_read_tr16_b64_v4i16((LAS s16x4*)(vp + 8 * VS)));
                const s16x4 lo1 = __builtin_bit_cast(s16x4, __builtin_amdgcn_ds_read_tr16_b64_v4i16((LAS s16x4*)(vp + 64)));
                const s16x4 hi1 = __builtin_bit_cast(s16x4, __builtin_amdgcn_ds_read_tr16_b64_v4i16((LAS s16x4*)(vp + 64 + 8 * VS)));
                const bf16x8 va0 = (bf16x8){lo0[0], lo0[1], lo0[2], lo0[3], hi0[0], hi0[1], hi0[2], hi0[3]};
                const bf16x8 va1 = (bf16x8){lo1[0], lo1[1], lo1[2], lo1[3], hi1[0], hi1[1], hi1[2], hi1[3]};
                o0 = __builtin_amdgcn_mfma_f32_32x32x16_bf16(va0, pb, o0, 0, 0, 0);
                o1 = __builtin_amdgcn_mfma_f32_32x32x16_bf16(va1, pb, o1, 0, 0, 0);
            }
        if (!last_chunk) { ++c; continue; }
        {
            const float l_tot = l_run + __shfl_xor(l_run, 32);
            const float inv = 1.0f / l_tot;
            const size_t tok = cur.tok0 + ((size_t)(cur.q0 + 32 * qh + r) << cur.sh);
            bf16_t* op = DIL ? ((cur.br == 2) ? (bf16_t*)(ws + WS_OP2) : (bf16_t*)(op01 + (size_t)cur.br * OP_BYTES)) : obuf;
            bf16_t* orow = op + tok * (DIL ? 512 : 1024) + (DIL ? cur.hsel * 256 : 512 + cur.hsel * 256) + hl * 64 + 4 * h;
#pragma unroll
            for (int g4 = 0; g4 < 4; ++g4) {
                u32x2 w0, w1;
                w0.x = pk2(o0[4 * g4 + 0] * inv, o0[4 * g4 + 1] * inv); w0.y = pk2(o0[4 * g4 + 2] * inv, o0[4 * g4 + 3] * inv);
                w1.x = pk2(o1[4 * g4 + 0] * inv, o1[4 * g4 + 1] * inv); w1.y = pk2(o1[4 * g4 + 2] * inv, o1[4 * g4 + 3] * inv);
                *(u32x2*)(orow + 8 * g4) = w0; *(u32x2*)(orow + 32 + 8 * g4) = w1;
            }
            if (DIL && h == 0) { float* lse = (float*)(ws + WS_LSE); lse[((size_t)cur.br * T + tok) * 8 + 4 * cur.hsel + hl] = m_run + __builtin_amdgcn_logf(l_tot); }
        }
        if (!has_next) break;
        i += G; cur = nxt; c = cur.c_lo;
#pragma unroll
        for (int s_ = 0; s_ < 4; ++s_) qf[s_] = qn[s_];
        ATT_INIT(cur);
        if (cur.hsel != hsel) {
            hsel = cur.hsel; __syncthreads();
            if (DIL) { att_fill_table(tb, rel, 1, hsel, tid); att_fill_table(tb, rel, 2, hsel, tid); att_fill_table(tb, rel, 3, hsel, tid); } else att_fill_table(tb, rel, 0, hsel, tid);
        }
    }
#undef ATT_COLS
#undef ATT_PREFETCH
#undef ATT_LOADQ
#undef ATT_INIT
}

struct Args { const float* in[16]; float* out; unsigned char* ws; int ph_lo, ph_hi, coop, pad; };
constexpr int LDS_BYTES = 147456;
constexpr int N_PHASES = 18;

__global__ void __launch_bounds__(512, 2) fwd_mega(Args args) {
    extern __shared__ __attribute__((aligned(16))) unsigned char lds_raw[];
    LAS unsigned char* lds = (LAS unsigned char*)lds_raw;
    cg::grid_group grid = cg::this_grid();
    const int ph_hi = args.ph_hi, coop = args.coop;
    if (threadIdx.x < 2) ((LAS unsigned*)(lds + LDS_BARST_OFF))[threadIdx.x] = 0u;
    __syncthreads();
    XcdBarrier xbar; xbar.bar = (unsigned*)(args.ws + WS_BAR); xbar.x = 0; xbar.st = (volatile LAS unsigned*)(lds + LDS_BARST_OFF);
    bool posted = false;
    for (int ph = args.ph_lo; ph < ph_hi; ++ph) {
        int tid = threadIdx.x; asm volatile("" : "+v"(tid));
        int bidx = blockIdx.x; asm volatile("" : "+s"(bidx));
        const __attribute__((address_space(4))) Args* ap = (const __attribute__((address_space(4))) Args*)__builtin_amdgcn_kernarg_segment_ptr(); asm volatile("" : "+s"(ap));
        const int lane = tid & 63, wave = __builtin_amdgcn_readfirstlane(tid >> 6);
        const int G = gridDim.x, gw = bidx * 8 + wave, NGW = G * 8;
        unsigned char* ws = ap->ws;
        float* ssb = (float*)(ws + WS_SS);
        bf16_t* XB = (bf16_t*)(ws + WS_XB); bf16_t* OB = (bf16_t*)(ws + WS_O); bf16_t* HB = (bf16_t*)(ws + WS_H);
        float* out = ap->out;
        if (ph == 0) {
            LAS float* scr = (LAS float*)(lds + wave * 16384);
            constexpr int I_GU = (DM / 64) * (FF / 32), I_DN = (FF / 64) * (DM / 32), I_IN = (DM / 64) * (NQKV / 32), I_WO = (DM / 64) * (DM / 32);
            constexpr int I_LAYER = 4 * I_GU + 2 * I_DN + I_IN + I_WO;
            for (int it = gw; it < 2 * I_LAYER; it += NGW) {
                const int l = it / I_LAYER; int rr = it % I_LAYER;
                unsigned char* wl = ws + WS_W + (size_t)l * WL_BYTES;
                if (rr < I_GU) { transpose_item(ap->in[4] + (size_t)l * DM * FF, DM, FF, ap->in[3] + l * DM, (bf16_t*)(wl + WL_W1A), 1, scr, rr, lane); continue; } rr -= I_GU;
                if (rr < I_GU) { transpose_item(ap->in[5] + (size_t)l * DM * FF, DM, FF, ap->in[3] + l * DM, (bf16_t*)(wl + WL_W1A), 2, scr, rr, lane); continue; } rr -= I_GU;
                if (rr < I_DN) { transpose_item(ap->in[6] + (size_t)l * FF * DM, FF, DM, nullptr, (bf16_t*)(wl + WL_W2A), 0, scr, rr, lane); continue; } rr -= I_DN;
                if (rr < I_GU) { transpose_item(ap->in[12] + (size_t)l * DM * FF, DM, FF, ap->in[11] + l * DM, (bf16_t*)(wl + WL_W1B), 1, scr, rr, lane); continue; } rr -= I_GU;
                if (rr < I_GU) { transpose_item(ap->in[13] + (size_t)l * DM * FF, DM, FF, ap->in[11] + l * DM, (bf16_t*)(wl + WL_W1B), 2, scr, rr, lane); continue; } rr -= I_GU;
                if (rr < I_DN) { transpose_item(ap->in[14] + (size_t)l * FF * DM, FF, DM, nullptr, (bf16_t*)(wl + WL_W2B), 0, scr, rr, lane); continue; } rr -= I_DN;
                if (rr < I_IN) { transpose_item(ap->in[8] + (size_t)l * DM * NQKV, DM, NQKV, ap->in[7] + l * DM, (bf16_t*)(wl + WL_WIN), 0, scr, rr, lane); continue; } rr -= I_IN;
                transpose_item(ap->in[9] + (size_t)l * DM * DM, DM, DM, nullptr, (bf16_t*)(wl + WL_WO), 0, scr, rr, lane);
            }
            for (int row = gw; row < T; row += NGW) {
                const float* src = (row >= TP) ? ap->in[1] + (size_t)(row - TP) * DM : ap->in[0] + (size_t)row * DM;
                const f32x4* xr = (const f32x4*)src + lane; f32x4 v[4]; float s = 0.f;
#pragma unroll
                for (int j = 0; j < 4; ++j) { v[j] = xr[64 * j]; s += (v[j][0] * v[j][0] + v[j][1] * v[j][1]) + (v[j][2] * v[j][2] + v[j][3] * v[j][3]); }
                s = wave_sum(s);
                u32x2* o8 = (u32x2*)(XB + (size_t)row * DM) + lane;
#pragma unroll
                for (int j = 0; j < 4; ++j) { u32x2 w; w.x = pk2(v[j][0], v[j][1]); w.y = pk2(v[j][2], v[j][3]); o8[64 * j] = w; }
                if (lane == 0) ssb[row] = s;
            }
            for (int i = bidx * 512 + tid; i < 6 * T; i += G * 512) ssb[T + i] = 0.f;
            if (bidx == 0) { unsigned* bw = (unsigned*)(ws + WS_BAR); for (int i = tid; i < XCD_BAR_WORDS; i += 512) bw[i] = 0u; }
        } else if (ph == N_PHASES - 1) {
            const float* ss = ssb + 6 * (size_t)T; const float* gf = ap->in[15];
            f32x4 gv[4];
#pragma unroll
            for (int j = 0; j < 4; ++j) gv[j] = ((const f32x4*)gf)[lane + 64 * j];
            for (int row = gw; row < T; row += NGW) {
                const float rs = __builtin_amdgcn_rsqf(ss[row] * (1.0f / 1024.0f) + EPS);
                f32x4* xr = (f32x4*)(out + (size_t)row * DM) + lane;
#pragma unroll
                for (int j = 0; j < 4; ++j) { f32x4 v = xr[64 * j]; v = v * rs * gv[j]; xr[64 * j] = v; }
            }
        } else {
            const int l = (ph - 1) >> 3, k = (ph - 1) & 7;
            const int rev = (k == 1 || k == 7 || k == 5) ? 1 : 0;
            unsigned char* wl = ws + WS_W + (size_t)l * WL_BYTES;
            if (k == 0 || k == 6) {
                const float* ss = ssb + (size_t)(3 * l + (k == 0 ? 0 : 2)) * T;
                if (SKEW1_TICKS > 0 && 2 * bidx >= G) { const unsigned long long t0 = __builtin_amdgcn_s_memrealtime(); while (__builtin_amdgcn_s_memrealtime() - t0 < (unsigned long long)SKEW1_TICKS) __builtin_amdgcn_s_sleep(8); }
                pg8::Gemm g{XB, (const bf16_t*)(wl + (k == 0 ? WL_W1A : WL_W1B)), T, 2 * FF, DM};
                pg8::StaticOrder S; S.init(T, 2 * FF, G, bidx, rev);
                pg8::EpiSwiGLU E{HB, ss};
                pg8::gemm_phase<pg8::EpiSwiGLU, pg8::StaticOrder>(lds, tid, g, S, E);
            } else if (k == 1 || k == 7 || k == 5) {
                const bool first = (l == 0 && k == 1), lastp = (l == 1 && k == 7);
                const float* sA = first ? ap->in[0] : nullptr; const float* sB = first ? ap->in[1] : nullptr;
                bf16_t* XL = (bf16_t*)(ws + WS_XL);
                float* ssn = ssb + (size_t)(3 * l + (k == 1 ? 1 : (k == 5 ? 2 : 3))) * T;
                if (k == 5) {
                    pg8::Gemm g{OB, (const bf16_t*)(wl + WL_WO), T, DM, DM};
                    pg8::StaticOrder S; S.init(T, DM, G, bidx, rev);
                    pg8::EpiRes E{sA, sB, XB, XL, nullptr, ssn, 1.0f};
                    pg8::gemm_phase<pg8::EpiRes, pg8::StaticOrder>(lds, tid, g, S, E);
                } else {
                    pg8::Gemm g{HB, (const bf16_t*)(wl + (k == 1 ? WL_W2A : WL_W2B)), T, DM, FF};
                    pg8::StaticOrder S; S.init(T, DM, G, bidx, rev);
                    pg8::EpiRes E{sA, sB, XB, XL, lastp ? out : nullptr, ssn, 0.5f};
                    pg8::gemm_phase<pg8::EpiRes, pg8::StaticOrder>(lds, tid, g, S, E);
                }
            } else if (k == 2) {
                const float* ss = ssb + (size_t)(3 * l + 1) * T;
                pg8::Gemm g{XB, (const bf16_t*)(wl + WL_WIN), T, NQKV, DM};
                pg8::StaticOrder S; S.init(T, NQKV, G, bidx, rev);
                pg8::EpiQKV E{HB, ss};
                pg8::gemm_phase<pg8::EpiQKV, pg8::StaticOrder>(lds, tid, g, S, E);
            } else if (k == 3) {
                const float* rel = ap->in[2]; const float* sink = ap->in[10] + l * 8;
                {
                    const int vcu = (G % 8 == 0) ? (bidx % 8) * (G / 8) + bidx / 8 : bidx;
                    int iB = vcu, iD = vcu;
                    while (iD < 2560) iD += G;
                    attn_stream<false>(lds, tid, HB, rel, sink, OB, ws, (unsigned char*)out, iB, 2560, G, 0);
                    attn_stream<true>(lds, tid, HB, rel, sink, OB, ws, (unsigned char*)out, iD, 2560 + 7680, G, 2560);
                }
                __syncthreads();
            } else {
                const float* lse = (const float*)(ws + WS_LSE);
                const bf16_t* p0 = (const bf16_t*)out; const bf16_t* p1 = (const bf16_t*)((const unsigned char*)out + OP_BYTES); const bf16_t* p2 = (const bf16_t*)(ws + WS_OP2);
                for (size_t idx = (size_t)bidx * 512 + tid; idx < (size_t)T * 32; idx += (size_t)G * 512) {
                    const size_t tok = idx >> 5; const int hd = (int)(idx >> 2) & 7, c16 = (int)idx & 3;
                    const float l0 = lse[tok * 8 + hd], l1 = lse[((size_t)T + tok) * 8 + hd], l2 = lse[((size_t)2 * T + tok) * 8 + hd];
                    const size_t off = tok * 512 + hd * 64 + c16 * 16;
                    u32x4 a[2], bq[2], cq[2];
#pragma unroll
                    for (int e = 0; e < 2; ++e) { a[e] = *(const u32x4*)(p0 + off + 8 * e); bq[e] = *(const u32x4*)(p1 + off + 8 * e); cq[e] = *(const u32x4*)(p2 + off + 8 * e); }
                    const float mx = fmaxf(l0, fmaxf(l1, l2));
                    float w0 = __builtin_amdgcn_exp2f(l0 - mx), w1 = __builtin_amdgcn_exp2f(l1 - mx), w2 = __builtin_amdgcn_exp2f(l2 - mx);
                    const float inv = 1.0f / (w0 + w1 + w2); w0 *= inv; w1 *= inv; w2 *= inv;
#pragma unroll
                    for (int e = 0; e < 2; ++e) {
                        u32x4 o;
#pragma unroll
                        for (int j = 0; j < 4; ++j) {
                            const float a_lo = __uint_as_float(a[e][j] << 16), a_hi = __uint_as_float(a[e][j] & 0xffff0000u);
                            const float b_lo = __uint_as_float(bq[e][j] << 16), b_hi = __uint_as_float(bq[e][j] & 0xffff0000u);
                            const float c_lo = __uint_as_float(cq[e][j] << 16), c_hi = __uint_as_float(cq[e][j] & 0xffff0000u);
                            o[j] = pk2(w0 * a_lo + w1 * b_lo + w2 * c_lo, w0 * a_hi + w1 * b_hi + w2 * c_hi);
                        }
                        *(u32x4*)(OB + tok * 1024 + hd * 64 + c16 * 16 + 8 * e) = o;
                    }
                }
            }
        }
        if (ph + 1 < ph_hi && coop) {
            if (!posted) { grid.sync(); xbar = xcd_barrier_post((unsigned*)(args.ws + WS_BAR), (volatile LAS unsigned*)(lds + LDS_BARST_OFF)); posted = true; }
            else xcd_barrier(xbar);
        }
    }
}

extern "C" void kernel_launch(void* const* d_in, const int* in_sizes, int n_in, void* d_out, int out_size, void* d_ws, size_t ws_size, hipStream_t stream) {
    static int grid = 0;
    if (grid == 0) {
        if (n_in != 16 || out_size != T * DM || ws_size < WS_END) { fprintf(stderr, "kernel_launch: unexpected shapes (n_in %d out %d ws %zu)\n", n_in, out_size, ws_size); grid = -1; return; }
        int dev = 0, cus = 0, per_cu = 0;
        hipGetDevice(&dev); hipDeviceGetAttribute(&cus, hipDeviceAttributeMultiprocessorCount, dev);
        if (hipFuncSetAttribute((const void*)fwd_mega, hipFuncAttributeMaxDynamicSharedMemorySize, LDS_BYTES) != hipSuccess) { fprintf(stderr, "kernel_launch: hipFuncSetAttribute failed\n"); grid = -1; return; }
        if (hipOccupancyMaxActiveBlocksPerMultiprocessor(&per_cu, (const void*)fwd_mega, 512, LDS_BYTES) != hipSuccess || per_cu < 1) per_cu = 1;
        (void)hipGetLastError();
        grid = cus * per_cu;
    }
    if (grid < 0) return;
    Args a{};
    for (int i = 0; i < 16; ++i) a.in[i] = (const float*)d_in[i];
    a.out = (float*)d_out; a.ws = (unsigned char*)d_ws;
#if MK_PER_PHASE
    for (int ph = 0; ph < N_PHASES; ++ph) {
        a.ph_lo = ph; a.ph_hi = ph + 1; a.coop = 0;
        hipLaunchKernelGGL(fwd_mega, dim3(grid), dim3(512), LDS_BYTES, stream, a);
    }
#else
    a.ph_lo = 0; a.ph_hi = N_PHASES; a.coop = 1;
    void* kargs[] = {&a};
    hipError_t e = hipLaunchCooperativeKernel((const void*)fwd_mega, dim3(grid), dim3(512), kargs, LDS_BYTES, stream);
    if (e != hipSuccess) fprintf(stderr, "cooperative launch failed: %s (grid %d)\n", hipGetErrorString(e), grid);
#endif
}
```

```cpp
#include <hip/hip_runtime.h>
#include <hip/hip_cooperative_groups.h>
#include <cstdio>
#include <cstdint>
namespace cg = cooperative_groups;

#ifndef MK_PER_PHASE
#define MK_PER_PHASE 0
#endif

#ifndef SKEW1_TICKS
#define SKEW1_TICKS 0
#endif
#ifndef XLO
#define XLO 0
#endif
#define LAS __attribute__((address_space(3)))
typedef unsigned short bf16_t;
typedef short bf16x8 __attribute__((ext_vector_type(8)));
typedef float f32x4 __attribute__((ext_vector_type(4)));
typedef float f32x16 __attribute__((ext_vector_type(16)));
typedef unsigned u32x4 __attribute__((ext_vector_type(4)));
typedef unsigned u32x2 __attribute__((ext_vector_type(2)));
typedef short s16x4 __attribute__((ext_vector_type(4)));

constexpr int T = 81920, TP = 65536, DM = 1024, FF = 2816, NQKV = 2304, SEQ = 4096, NSEQ = 20;
constexpr float EPS = 1e-6f, LOG2E = 1.4426950408889634f;
constexpr float QSCALE = 0.125f * LOG2E;

constexpr size_t MiB = 1u << 20;
constexpr size_t WS_SS = 1 * MiB;
constexpr size_t WS_LSE = 4 * MiB;
constexpr size_t WS_W = 12 * MiB;
constexpr size_t W1_BYTES = (size_t)2 * FF * DM * 2, W2_BYTES = (size_t)DM * FF * 2, WIN_BYTES = (size_t)NQKV * DM * 2, WO_BYTES = (size_t)DM * DM * 2;
constexpr size_t WL_W1A = 0, WL_W2A = WL_W1A + W1_BYTES, WL_WIN = WL_W2A + W2_BYTES, WL_WO = WL_WIN + WIN_BYTES, WL_W1B = WL_WO + WO_BYTES, WL_W2B = WL_W1B + W1_BYTES, WL_BYTES = WL_W2B + W2_BYTES;
constexpr size_t WS_XB = 92 * MiB;
constexpr size_t WS_O = 252 * MiB;
constexpr size_t WS_H = 412 * MiB;
constexpr size_t WS_OP2 = 772 * MiB;
constexpr size_t WS_XL = 852 * MiB;
constexpr size_t WS_BAR = 1012 * MiB;
constexpr size_t WS_END = 1013 * MiB;
constexpr int LDS_BARST_OFF = 131072 + 512;
static_assert(WS_W + 2 * WL_BYTES <= WS_XB, "weights fit");
constexpr size_t OP_BYTES = (size_t)T * 512 * 2;

namespace pg8 {
constexpr int BM = 256, BK = 64, HALF = 128, HTB = HALF * BK * 2, STAGE_BYTES = 8 * HTB, NXCD = 8, WGM = 8;
__host__ __device__ __forceinline__ int lds_byte(int r, int c) { const int st = (r >> 4) * 2 + (c >> 5), rr = r & 15, cc = c & 31, ob = rr * 64 + cc * 2; return st * 1024 + (ob ^ (((ob >> 9) & 1) << 5)); }
__host__ __device__ __forceinline__ void stage_rc(int b, int& R, int& C) { const int st = b / 1024, sb = b % 1024, swz = sb ^ (((sb >> 9) & 1) << 5); R = (st >> 1) * 16 + swz / 64; C = (st & 1) * 32 + (swz % 64) / 2; }
__host__ __device__ __forceinline__ int perm32(int rho) { const int n = rho >> 4, i = rho & 15; return 8 * (i >> 2) + 4 * n + (i & 3); }
struct Unit { int pm, pn; };
struct Gemm { const bf16_t* A; const bf16_t* Bt; int M, N, K; };
struct StaticOrder {
    int nM, nN, nwg, G, c, rev;
    __device__ void init(int M, int N, int G_, int c_, int rev_) { nM = M / BM; nN = N / BM; nwg = nM * nN; G = G_; c = c_; rev = rev_; }
    __device__ bool next(int i, Unit& u) const {
        const long L = (long)i * G + c; if (L >= nwg) return false;
        int wgid = (int)L; { const int q = nwg / NXCD, r = nwg % NXCD, xcd = wgid % NXCD, off = wgid / NXCD; wgid = (xcd < r ? xcd * (q + 1) : r * (q + 1) + (xcd - r) * q) + off; }
        const int nig = WGM * nN, gid = wgid / nig, fm = gid * WGM, gsz = (nM - fm) < WGM ? (nM - fm) : WGM;
        u.pm = fm + ((wgid % nig) % gsz); u.pn = (wgid % nig) / gsz; if (rev) u.pm = nM - 1 - u.pm; return true;
    }
};
__device__ __forceinline__ unsigned cvt_pk_bf16(float lo, float hi) { unsigned r; asm volatile("v_cvt_pk_bf16_f32 %0, %1, %2" : "=v"(r) : "v"(lo), "v"(hi)); return r; }

struct EpiSwiGLU {
    static constexpr bool PERM = true;
    bf16_t* H; const float* ss;
    __device__ __forceinline__ void operator()(const f32x4 (&acc)[2][2][4][2], const Unit& u, int wr, int wc, int fr, int fq) const {
        const int row0 = u.pm * BM + wr * 64 + fr; const int col0 = u.pn * 128 + wc * 32 + 8 * fq;
#pragma unroll
        for (int ai = 0; ai < 2; ++ai)
#pragma unroll
            for (int m = 0; m < 4; ++m) {
                const int row = row0 + ai * HALF + m * 16;
                const float rs = __builtin_amdgcn_rsqf(ss[row] * (1.0f / 1024.0f) + EPS);
                const float rsn = -rs * LOG2E, rs2 = rs * rs;
                typedef float f32x2 __attribute__((ext_vector_type(2)));
                unsigned hw[4];
#pragma unroll
                for (int n = 0; n < 2; ++n)
#pragma unroll
                    for (int jp = 0; jp < 2; ++jp) {
                        const f32x2 a = (f32x2){acc[ai][0][m][n][2 * jp], acc[ai][0][m][n][2 * jp + 1]}, b = (f32x2){acc[ai][1][m][n][2 * jp], acc[ai][1][m][n][2 * jp + 1]};
                        const f32x2 t = a * rsn;
                        f32x2 e; e.x = __builtin_amdgcn_exp2f(t.x); e.y = __builtin_amdgcn_exp2f(t.y);
                        const f32x2 d = e + 1.0f;
                        f32x2 r; r.x = __builtin_amdgcn_rcpf(d.x); r.y = __builtin_amdgcn_rcpf(d.y);
                        const f32x2 hh = (a * b) * (r * rs2);
                        hw[n * 2 + jp] = cvt_pk_bf16(hh.x, hh.y);
                    }
                u32x4 w; w.x = hw[0]; w.y = hw[1]; w.z = hw[2]; w.w = hw[3];
                *(u32x4*)(H + (size_t)row * FF + col0) = w;
            }
    }
};
struct EpiQKV {
    static constexpr bool PERM = true;
    bf16_t* P; const float* ss;
    __device__ __forceinline__ void operator()(const f32x4 (&acc)[2][2][4][2], const Unit& u, int wr, int wc, int fr, int fq) const {
        const int row0 = u.pm * BM + wr * 64 + fr; const int col0 = u.pn * BM + wc * 32 + 8 * fq;
        const float cs = (u.pn < 2 || u.pn == 6 || u.pn == 7) ? QSCALE : 1.0f;
#pragma unroll
        for (int ai = 0; ai < 2; ++ai)
#pragma unroll
            for (int m = 0; m < 4; ++m) {
                const int row = row0 + ai * HALF + m * 16;
                const float rs = __builtin_amdgcn_rsqf(ss[row] * (1.0f / 1024.0f) + EPS) * cs;
#pragma unroll
                for (int bj = 0; bj < 2; ++bj) {
                    const f32x4 v0 = acc[ai][bj][m][0] * rs, v1 = acc[ai][bj][m][1] * rs;
                    u32x4 w; w.x = cvt_pk_bf16(v0[0], v0[1]); w.y = cvt_pk_bf16(v0[2], v0[3]); w.z = cvt_pk_bf16(v1[0], v1[1]); w.w = cvt_pk_bf16(v1[2], v1[3]);
                    *(u32x4*)(P + (size_t)row * NQKV + col0 + bj * HALF) = w;
                }
            }
    }
};
struct EpiRes {
    static constexpr bool PERM = true;
    const float* srcA; const float* srcB; bf16_t* xh; bf16_t* xl; float* outf; float* ssn; float alpha;
    __device__ __forceinline__ void operator()(const f32x4 (&acc)[2][2][4][2], const Unit& u, int wr, int wc, int fr, int fq) const {
        const int row0 = u.pm * BM + wr * 64 + fr; const int col0 = u.pn * BM + wc * 32 + 8 * fq;
        const float* srcbase = srcA ? ((u.pm * BM >= TP) ? srcB - (size_t)TP * DM : srcA) : nullptr;
#pragma unroll
        for (int am = 0; am < 4; ++am) {
            const int ai = am >> 1, m0 = (am & 1) * 2;
            f32x4 pre[2][2][2];
            if (srcbase) {
#pragma unroll
                for (int mm = 0; mm < 2; ++mm) { const float* src = srcbase + (size_t)(row0 + ai * HALF + (m0 + mm) * 16) * DM + col0;
#pragma unroll
                    for (int bj = 0; bj < 2; ++bj) { pre[mm][bj][0] = __builtin_nontemporal_load((const f32x4*)(src + bj * HALF)); pre[mm][bj][1] = __builtin_nontemporal_load((const f32x4*)(src + bj * HALF + 4)); } }
            } else {
                u32x4 rh[2][2], rl[2][2];
#pragma unroll
                for (int mm = 0; mm < 2; ++mm) { const size_t off = (size_t)(row0 + ai * HALF + (m0 + mm) * 16) * DM + col0;
#pragma unroll
                    for (int bj = 0; bj < 2; ++bj) { rh[mm][bj] = *(const u32x4*)(xh + off + bj * HALF); rl[mm][bj] = xl ? *(const u32x4*)(xl + off + bj * HALF) : (u32x4){0u, 0u, 0u, 0u}; } }
#pragma unroll
                for (int mm = 0; mm < 2; ++mm)
#pragma unroll
                    for (int bj = 0; bj < 2; ++bj)
#pragma unroll
                        for (int j = 0; j < 4; ++j) {
                            const float e0 = __uint_as_float(rh[mm][bj][j] << 16) + __uint_as_float(rl[mm][bj][j] << 16);
                            const float e1 = __uint_as_float(rh[mm][bj][j] & 0xffff0000u) + __uint_as_float(rl[mm][bj][j] & 0xffff0000u);
                            pre[mm][bj][j >> 1][2 * (j & 1)] = e0; pre[mm][bj][j >> 1][2 * (j & 1) + 1] = e1;
                        }
            }
#pragma unroll
            for (int mm = 0; mm < 2; ++mm) {
                const int m = m0 + mm;
                const int row = row0 + ai * HALF + m * 16;
                const size_t off = (size_t)row * DM + col0;
                float s = 0.f;
#pragma unroll
                for (int bj = 0; bj < 2; ++bj) {
                    const f32x4 a = pre[mm][bj][0] + acc[ai][bj][m][0] * alpha, b = pre[mm][bj][1] + acc[ai][bj][m][1] * alpha;
                    s += (a[0] * a[0] + a[1] * a[1]) + (a[2] * a[2] + a[3] * a[3]) + (b[0] * b[0] + b[1] * b[1]) + (b[2] * b[2] + b[3] * b[3]);
                    if (outf) { __builtin_nontemporal_store(a, (f32x4*)(outf + off + bj * HALF)); __builtin_nontemporal_store(b, (f32x4*)(outf + off + bj * HALF + 4)); }
                    else {
                        u32x4 wh, wl;
                        wh.x = cvt_pk_bf16(a[0], a[1]); wh.y = cvt_pk_bf16(a[2], a[3]); wh.z = cvt_pk_bf16(b[0], b[1]); wh.w = cvt_pk_bf16(b[2], b[3]);
                        wl.x = cvt_pk_bf16(a[0] - __uint_as_float(wh.x << 16), a[1] - __uint_as_float(wh.x & 0xffff0000u));
                        wl.y = cvt_pk_bf16(a[2] - __uint_as_float(wh.y << 16), a[3] - __uint_as_float(wh.y & 0xffff0000u));
                        wl.z = cvt_pk_bf16(b[0] - __uint_as_float(wh.z << 16), b[1] - __uint_as_float(wh.z & 0xffff0000u));
                        wl.w = cvt_pk_bf16(b[2] - __uint_as_float(wh.w << 16), b[3] - __uint_as_float(wh.w & 0xffff0000u));
                        *(u32x4*)(xh + off + bj * HALF) = wh; if (xl) *(u32x4*)(xl + off + bj * HALF) = wl;
                    }
                }
                s += __shfl_xor(s, 16); s += __shfl_xor(s, 32);
                if (fq == 0) atomicAdd(ssn + row, s);
            }
            asm volatile("" ::: "memory");
        }
    }
};

template <class Epi, class Sched>
__device__ __forceinline__ void gemm_phase(LAS unsigned char* lds, const int tid, const Gemm g, const Sched& S, const Epi& E) {
    const int wid = __builtin_amdgcn_readfirstlane(tid >> 6), lane = tid & 63, wr = wid >> 2, wc = wid & 3, fr = lane & 15, fq = lane >> 4;
    const int K = g.K, nt = K / BK;
    unsigned voffA[2], voffB[2];
#pragma unroll
    for (int i = 0; i < 2; ++i) { int R, C; stage_rc(tid * 16 + i * 8192, R, C); const int Rb = Epi::PERM ? ((R & ~31) + perm32(R & 31)) : R;
        voffA[i] = (unsigned)(R * K + C) * 2u; voffB[i] = (unsigned)(Rb * K + C) * 2u; }
    const size_t kstep = (size_t)(BK * 2);
    const size_t hstep = (size_t)HALF * K * 2;
    const size_t tstep = 2 * hstep;
    const unsigned ldsw = (unsigned)wid * 1024u;
    const int aoff = lds_byte(wr * 64 + fr, fq * 8), boff = lds_byte(wc * 32 + fr, fq * 8);
#define PG8_SA(b, h) (((b) * 2 + (h)) * HTB)
#define PG8_SB(b, h) ((4 + (b) * 2 + (h)) * HTB)
#define PG8_STAGE(bufoff, gbase, voff) do { _Pragma("unroll") for (int _i = 0; _i < 2; ++_i) \
        __builtin_amdgcn_global_load_lds((const unsigned*)((const char*)(gbase) + (voff)[_i]), (LAS unsigned*)(lds + (bufoff) + ldsw + _i * 8192), 16, 0, 0); } while (0)
#define PG8_LDA(dst, b, h) do { _Pragma("unroll") for (int m = 0; m < 4; ++m) _Pragma("unroll") for (int k = 0; k < 2; ++k) dst[m][k] = *(const LAS bf16x8*)(lds + PG8_SA(b, h) + aoff + m * 2048 + k * 1024); } while (0)
#define PG8_LDB(dst, b, h) do { _Pragma("unroll") for (int n = 0; n < 2; ++n) _Pragma("unroll") for (int k = 0; k < 2; ++k) dst[n][k] = *(const LAS bf16x8*)(lds + PG8_SB(b, h) + boff + n * 2048 + k * 1024); } while (0)
#define PG8_MMA(ai, bj, At, Bt) do { __builtin_amdgcn_s_setprio(1); _Pragma("unroll") for (int m = 0; m < 4; ++m) _Pragma("unroll") for (int n = 0; n < 2; ++n) _Pragma("unroll") for (int k = 0; k < 2; ++k) \
        acc[ai][bj][m][n] = __builtin_amdgcn_mfma_f32_16x16x32_bf16(Bt[n][k], At[m][k], acc[ai][bj][m][n], 0, 0, 0); __builtin_amdgcn_s_setprio(0); } while (0)
#define PG8_WAIT_V(n) asm volatile("s_waitcnt vmcnt(" #n ")" ::: "memory")
#define PG8_WAIT_L(n) asm volatile("s_waitcnt lgkmcnt(" #n ")" ::: "memory")
#define PG8_BAR __builtin_amdgcn_s_barrier()
#define PG8_SCHED __builtin_amdgcn_sched_barrier(0)
    Unit cur, nxt; int ui = 0;
    if (!S.next(0, cur)) return;
    f32x4 acc[2][2][4][2];
#pragma unroll
    for (int a = 0; a < 2; ++a)
#pragma unroll
        for (int b = 0; b < 2; ++b)
#pragma unroll
            for (int m = 0; m < 4; ++m)
#pragma unroll
                for (int n = 0; n < 2; ++n) acc[a][b][m][n] = (f32x4){0.f, 0.f, 0.f, 0.f};
    bf16x8 At[4][2], B0[2][2], B1[2][2];
    const char* cA = (const char*)g.A + (size_t)cur.pm * tstep; const char* cB = (const char*)g.Bt + (size_t)cur.pn * tstep;
    PG8_STAGE(PG8_SB(0, 0), cB, voffB); PG8_STAGE(PG8_SB(0, 1), cB + hstep, voffB); PG8_STAGE(PG8_SA(0, 0), cA, voffA); PG8_STAGE(PG8_SA(0, 1), cA + hstep, voffA);
    if (wr == 1) PG8_BAR;
    PG8_WAIT_V(2); PG8_BAR;
    PG8_STAGE(PG8_SB(1, 0), cB + kstep, voffB); PG8_STAGE(PG8_SA(1, 0), cA + kstep, voffA); PG8_STAGE(PG8_SB(1, 1), cB + hstep + kstep, voffB);
    PG8_WAIT_V(6); PG8_BAR;
    for (;;) {
        const bool has_next = S.next(ui + 1, nxt);
        const char* nA = has_next ? (const char*)g.A + (size_t)nxt.pm * tstep : cA; const char* nB = has_next ? (const char*)g.Bt + (size_t)nxt.pn * tstep : cB;
        for (int t = 0; t < nt; t += 2) {
            const bool last = (t == nt - 2);
            const char* a1 = cA + (size_t)(t + 1) * kstep;
            const char* a2 = last ? nA : cA + (size_t)(t + 2) * kstep; const char* b2 = last ? nB : cB + (size_t)(t + 2) * kstep;
            const char* a3 = a2 + kstep; const char* b3 = b2 + kstep;
            PG8_LDB(B0, 0, 0); PG8_LDB(B1, 0, 1); PG8_SCHED; PG8_LDA(At, 0, 0); PG8_STAGE(PG8_SA(1, 1), a1 + hstep, voffA);
            PG8_WAIT_V(8); PG8_WAIT_L(0); PG8_BAR; PG8_MMA(0, 0, At, B0); PG8_MMA(0, 1, At, B1); PG8_BAR; PG8_SCHED;
            PG8_LDA(At, 0, 1); PG8_STAGE(PG8_SB(0, 0), b2, voffB); PG8_STAGE(PG8_SB(0, 1), b2 + hstep, voffB); PG8_STAGE(PG8_SA(0, 0), a2, voffA);
            PG8_WAIT_V(8); PG8_WAIT_L(0); PG8_BAR; PG8_MMA(1, 0, At, B0); PG8_MMA(1, 1, At, B1); PG8_BAR; PG8_SCHED;
            PG8_LDB(B0, 1, 0); PG8_LDB(B1, 1, 1); PG8_SCHED; PG8_LDA(At, 1, 0); PG8_STAGE(PG8_SA(0, 1), a2 + hstep, voffA);
            PG8_WAIT_V(8); PG8_WAIT_L(0); PG8_BAR; PG8_MMA(0, 0, At, B0); PG8_MMA(0, 1, At, B1); PG8_BAR; PG8_SCHED;
            PG8_LDA(At, 1, 1); PG8_STAGE(PG8_SB(1, 0), b3, voffB); PG8_STAGE(PG8_SB(1, 1), b3 + hstep, voffB); PG8_STAGE(PG8_SA(1, 0), a3, voffA);
            PG8_WAIT_V(8); PG8_WAIT_L(0); PG8_BAR; PG8_MMA(1, 0, At, B0); PG8_MMA(1, 1, At, B1); PG8_BAR; PG8_SCHED;
        }
        if (wr == 0) PG8_BAR;
        E(acc, cur, wr, wc, fr, fq);
        if (!has_next) break;
#pragma unroll
        for (int a = 0; a < 2; ++a)
#pragma unroll
            for (int b = 0; b < 2; ++b)
#pragma unroll
                for (int m = 0; m < 4; ++m)
#pragma unroll
                    for (int n = 0; n < 2; ++n) acc[a][b][m][n] = (f32x4){0.f, 0.f, 0.f, 0.f};
        cur = nxt; cA = nA; cB = nB; ++ui;
        if (wr == 1) PG8_BAR;
    }
    PG8_WAIT_V(0);
    PG8_BAR;
#undef PG8_SA
#undef PG8_SB
#undef PG8_STAGE
#undef PG8_LDA
#undef PG8_LDB
#undef PG8_MMA
#undef PG8_WAIT_V
#undef PG8_WAIT_L
#undef PG8_BAR
#undef PG8_SCHED
}
}

#define XB_TMO      128
#define XB_XCNT(j)  (256  + 64 * (j))
#define XB_XSUB(j)  (1280 + 64 * (j))
#define XB_XGEN(j)  (2304 + 64 * (j))
#define XB_TOP      3328
#define XB_TOPGEN   3392
#define XCD_BAR_WORDS 3456
#define XB_SPIN_CAP (1u << 18)

__device__ __forceinline__ unsigned xb_ld(unsigned* p)              { return __hip_atomic_load(p, __ATOMIC_RELAXED, __HIP_MEMORY_SCOPE_AGENT); }
__device__ __forceinline__ unsigned xb_add(unsigned* p, unsigned v) { return __hip_atomic_fetch_add(p, v, __ATOMIC_RELAXED, __HIP_MEMORY_SCOPE_AGENT); }
__device__ __forceinline__ unsigned xb_xcc_id() { return (unsigned)__builtin_amdgcn_s_getreg((3 << 11) | 20) & 0xFu; }
#define XB_SPIN(cond, bar) do { unsigned _sp = 0; while (cond) { __builtin_amdgcn_s_sleep(1); \
    if ((++_sp & 255u) == 0u) { if (xb_ld(&(bar)[XB_TMO])) break; if (_sp > XB_SPIN_CAP) { atomicAdd(&(bar)[XB_TMO], 1u); break; } } } } while (0)

struct XcdBarrier {
    unsigned* bar; unsigned x;
    volatile LAS unsigned* st;
};

__device__ __forceinline__ XcdBarrier xcd_barrier_post(unsigned* bar, volatile LAS unsigned* st) {
    XcdBarrier b; b.bar = bar; b.x = xb_xcc_id(); b.st = st;
    if (threadIdx.x == 0) (void)xb_add(&bar[XB_XCNT(b.x)], 1u);
    return b;
}
__device__ __forceinline__ void xcd_barrier_complete(unsigned* bar, unsigned x, unsigned& nloc, unsigned& nx) {
    const unsigned G = gridDim.x * gridDim.y * gridDim.z;
    unsigned sum, cnt, mine, sp = 0u;
    for (;;) {
        sum = 0u; cnt = 0u; mine = 0u;
#pragma unroll
        for (unsigned j = 0; j < 16; ++j) { const unsigned c = xb_ld(&bar[XB_XCNT(j)]); sum += c; cnt += (c > 0u) ? 1u : 0u; mine = (j == x) ? c : mine; }
        if (sum == G) break;
        __builtin_amdgcn_s_sleep(1);
        if ((++sp & 255u) == 0u) { if (xb_ld(&bar[XB_TMO])) break; if (sp > XB_SPIN_CAP) { atomicAdd(&bar[XB_TMO], 1u); break; } }
    }
    nloc = mine > 0u ? mine : 1u; nx = cnt > 0u ? cnt : 1u;
}

__device__ __forceinline__ void xcd_barrier(const XcdBarrier& b) {
    asm volatile("s_waitcnt vmcnt(0)" ::: "memory");
    __syncthreads();
    if (threadIdx.x == 0) {
        unsigned* bar = b.bar;
        __builtin_amdgcn_s_waitcnt(0);
        unsigned nloc = b.st[0], nx = b.st[1];
        if (nloc == 0u) { xcd_barrier_complete(bar, b.x, nloc, nx); b.st[0] = nloc; b.st[1] = nx; }
        const unsigned old = xb_add(&bar[XB_XSUB(b.x)], 1u);
        const unsigned gen = old / nloc;
        if (old + 1u == (gen + 1u) * nloc) {
            __builtin_amdgcn_fence(__ATOMIC_RELEASE, "agent");
            asm volatile("s_waitcnt vmcnt(0)" ::: "memory");
            const unsigned og = xb_add(&bar[XB_TOP], 1u);
            const unsigned tg = og / nx;
            if (og + 1u == (tg + 1u) * nx) xb_add(&bar[XB_TOPGEN], 1u);
            else XB_SPIN(xb_ld(&bar[XB_TOPGEN]) == tg, bar);
            __builtin_amdgcn_fence(__ATOMIC_ACQUIRE, "agent");
            xb_add(&bar[XB_XGEN(b.x)], 1u);
            asm volatile("s_waitcnt vmcnt(0)" ::: "memory");
        } else {
            XB_SPIN(xb_ld(&bar[XB_XGEN(b.x)]) == gen, bar);
            __builtin_amdgcn_fence(__ATOMIC_ACQUIRE, "agent");
            asm volatile("s_waitcnt vmcnt(0)" ::: "memory");
        }
    }
    __syncthreads();
}


__device__ __forceinline__ float wave_sum(float v) {
#pragma unroll
    for (int o = 1; o < 64; o <<= 1) v += __shfl_xor(v, o);
    return v;
}
__device__ __forceinline__ unsigned pk2(float lo, float hi) { return pg8::cvt_pk_bf16(lo, hi); }
__device__ __forceinline__ int rel_bucket(int rel) {
    const int n = rel < 0 ? -rel : rel;
    const int v = n < 8 ? n : 8 + (n >= 15) + (n >= 27) + (n >= 50) + (n >= 91) + (n >= 166) + (n >= 305) + (n >= 559);
    return (rel > 0 ? 16 : 0) + v;
}

__device__ __forceinline__ void transpose_item(const float* W, int K, int N, const float* gain, bf16_t* WT, int mode, LAS float* scr, int item, int lane) {
    const int nblk = N / 32, kb = item / nblk, nb = item % nblk, k0 = 64 * kb, n0 = 32 * nb;
#pragma unroll 8
    for (int i = 0; i < 32; ++i) { const int kk = 2 * i + (lane >> 5); float w = W[(size_t)(k0 + kk) * N + n0 + (lane & 31)]; if (gain) w *= gain[k0 + kk]; scr[kk * 33 + (lane & 31)] = w; }
    asm volatile("s_waitcnt lgkmcnt(0)" ::: "memory");
    const int c = lane & 7;
    const int d0 = (mode == 0) ? n0 : ((n0 >> 7) * 256 + (n0 & 127) + (mode == 2 ? 128 : 0));
#pragma unroll
    for (int j = 0; j < 4; ++j) { const int n = (lane >> 3) + 8 * j; const LAS float* s = scr + (8 * c) * 33 + n;
        u32x4 o; o.x = pk2(s[0 * 33], s[1 * 33]); o.y = pk2(s[2 * 33], s[3 * 33]); o.z = pk2(s[4 * 33], s[5 * 33]); o.w = pk2(s[6 * 33], s[7 * 33]);
        *(u32x4*)(WT + (size_t)(d0 + n) * K + k0 + 8 * c) = o; }
    asm volatile("s_waitcnt lgkmcnt(0)" ::: "memory");
}

constexpr int ATT_V_OFF = 36864, ATT_TB_OFF = 73728, ATT_TB_N = 384, ATT_TB_VAR = 4 * ATT_TB_N;
struct AttUnit { size_t tok0; int sh, q0, c_lo, c_hi, br, hsel; };
template <bool DIL>
__device__ __forceinline__ AttUnit att_decode(int u) {
    AttUnit p;
    if (DIL) {
        const int blk = (u >> 1) & 63, rest = u >> 7; p.hsel = u & 1; p.br = rest % 3; const int b = rest / 3; p.sh = 2 * p.br;
        const int nb = 64 >> p.sh, rho = blk >> (6 - p.sh); p.q0 = 64 * (blk & (nb - 1));
        p.tok0 = (size_t)b * SEQ + rho;
        const int Ls = SEQ >> p.sh; p.c_lo = (p.q0 == 0) ? 1 : 0; p.c_hi = (p.q0 + 64 >= Ls) ? 1 : 2;
    } else {
        p.hsel = u & 1; const int tile = (u >> 1) & 63, b = u >> 7; p.q0 = 64 * tile; p.br = 0; p.sh = 0; p.tok0 = (size_t)b * SEQ;
        p.c_lo = (p.q0 >= 128) ? 0 : (p.q0 >= 64 ? 1 : 2); p.c_hi = (p.q0 + 192 <= SEQ) ? 4 : (p.q0 + 128 <= SEQ ? 3 : 2);
    }
    return p;
}
__device__ __forceinline__ void att_fill_table(LAS float* tb, const float* rel, int variant, int hsel, int tid) {
    const int win = variant == 0 ? 128 : 64, d = variant == 0 ? 1 : (1 << (2 * (variant - 1))), bhead = variant == 0 ? 8 + 4 * hsel : 4 * hsel;
    for (int e = tid; e < ATT_TB_VAR; e += 512) {
        const int hh = e / ATT_TB_N, idx = e % ATT_TB_N, delta = idx - 191;
        float v = -1e30f;
        if (delta >= -win && delta <= win) v = rel[rel_bucket(delta * d) * 16 + bhead + hh] * LOG2E;
        tb[variant * ATT_TB_VAR + e] = v;
    }
}
template <bool DIL>
__device__ __forceinline__ void attn_stream(LAS unsigned char* lds, const int tid, const bf16_t* proj, const float* rel, const float* sink, bf16_t* obuf, unsigned char* ws, unsigned char* op01,
                                            int i, const int i_end, const int G, const int ubase) {
    if (i >= i_end) return;
    constexpr int PPK = DIL ? 32 : 8, NIT = DIL ? 4 : 1, KS = DIL ? 528 : 144, VS = DIL ? 576 : 192, KFIRST = DIL ? -64 : -128;
    const int lane = tid & 63, wid = __builtin_amdgcn_readfirstlane(tid >> 6);
    const int hl = wid >> 1, qh = wid & 1, r = lane & 31, h = lane >> 5;
    LAS float* tb = (LAS float*)(lds + ATT_TB_OFF);
    AttUnit cur = att_decode<DIL>(i - ubase), nxt = cur;
    int hsel = cur.hsel;
    __syncthreads();
    if (DIL) { att_fill_table(tb, rel, 1, hsel, tid); att_fill_table(tb, rel, 2, hsel, tid); att_fill_table(tb, rel, 3, hsel, tid); } else att_fill_table(tb, rel, 0, hsel, tid);
    const int hlk = DIL ? hl : 0;
    const LAS unsigned char* kread = lds + r * KS + hlk * 128 + 16 * h;
    const LAS unsigned char* vread = lds + ATT_V_OFF + (4 * h + ((lane & 15) >> 2)) * VS + (hlk * 64 + 16 * ((lane >> 4) & 1) + 4 * (lane & 3)) * 2;
    u32x4 kreg[NIT], vreg[NIT];
    bf16x8 qf[4], qn[4];
#define ATT_COLS(P) const int qcol = DIL ? (P).hsel * 256 : 1536 + (P).hsel * 256, kcol = DIL ? 512 + (P).hsel * 256 : 2048 + (P).hsel * 64, vcol = DIL ? 1024 + (P).hsel * 256 : 2176 + (P).hsel * 64
#define ATT_PREFETCH(P, c) do { ATT_COLS(P); (void)qcol; const int ks0 = (P).q0 + KFIRST + 64 * (c); const bf16_t* kb_ = proj + (P).tok0 * NQKV; const size_t ts_ = (size_t)NQKV << (P).sh; \
        _Pragma("unroll") for (int it = 0; it < NIT; ++it) { const int p = tid + 512 * it, key = p / PPK, hc = p % PPK; \
        const bf16_t* src = kb_ + (size_t)(ks0 + key) * ts_ + hc * 8; kreg[it] = *(const u32x4*)(src + kcol); vreg[it] = *(const u32x4*)(src + vcol); } } while (0)
#define ATT_LOADQ(P, Q) do { ATT_COLS(P); (void)kcol; (void)vcol; const bf16_t* qrow = proj + ((P).tok0 + ((size_t)((P).q0 + 32 * qh + r) << (P).sh)) * NQKV + qcol + hl * 64 + 8 * h; \
        _Pragma("unroll") for (int s_ = 0; s_ < 4; ++s_) Q[s_] = *(const bf16x8*)(qrow + 16 * s_); } while (0)
    ATT_LOADQ(cur, qf);
    int c = cur.c_lo;
    ATT_PREFETCH(cur, c);
    float m_run, l_run; f32x16 o0, o1;
#define ATT_INIT(P) do { if (DIL) { m_run = -1e30f; l_run = 0.f; } else { m_run = sink[4 * (P).hsel + hl] * LOG2E; l_run = (h == 0) ? 1.0f : 0.0f; } \
        _Pragma("unroll") for (int i_ = 0; i_ < 16; ++i_) { o0[i_] = 0.f; o1[i_] = 0.f; } } while (0)
    ATT_INIT(cur);
    for (;;) {
        __syncthreads();
#pragma unroll
        for (int it = 0; it < NIT; ++it) { const int p = tid + 512 * it, key = p / PPK, hc = p % PPK;
            *(LAS u32x4*)(lds + key * KS + hc * 16) = kreg[it]; *(LAS u32x4*)(lds + ATT_V_OFF + key * VS + hc * 16) = vreg[it]; }
        __syncthreads();
        const bool last_chunk = (c == cur.c_hi), has_next = (i + G < i_end);
        if (!last_chunk) ATT_PREFETCH(cur, c + 1);
        else if (has_next) { nxt = att_decode<DIL>(i + G - ubase); ATT_PREFETCH(nxt, nxt.c_lo); ATT_LOADQ(nxt, qn); }
        f32x16 x0, x1;
        const LAS float* tbp = tb + (DIL ? 1 + cur.br : 0) * ATT_TB_VAR + hl * ATT_TB_N + (KFIRST + 64 * c + 191 + 4 * h - 32 * qh - r);
#pragma unroll
        for (int i_ = 0; i_ < 16; ++i_) { const int ko = (i_ & 3) + 8 * (i_ >> 2); x0[i_] = tbp[ko]; x1[i_] = tbp[32 + ko]; }
#pragma unroll
        for (int s = 0; s < 4; ++s) {
            const bf16x8 a0 = *(const LAS bf16x8*)(kread + s * 32), a1 = *(const LAS bf16x8*)(kread + 32 * KS + s * 32);
            x0 = __builtin_amdgcn_mfma_f32_32x32x16_bf16(a0, qf[s], x0, 0, 0, 0);
            x1 = __builtin_amdgcn_mfma_f32_32x32x16_bf16(a1, qf[s], x1, 0, 0, 0);
        }
        float mx = -1e30f;
#pragma unroll
        for (int i_ = 0; i_ < 16; ++i_) mx = fmaxf(mx, fmaxf(x0[i_], x1[i_]));
        mx = fmaxf(mx, __shfl_xor(mx, 32));
        const float m_new = fmaxf(m_run, mx), alpha = __builtin_amdgcn_exp2f(m_run - m_new); m_run = m_new;
        float rsum = 0.f;
#pragma unroll
        for (int i_ = 0; i_ < 16; ++i_) { x0[i_] = __builtin_amdgcn_exp2f(x0[i_] - m_new); x1[i_] = __builtin_amdgcn_exp2f(x1[i_] - m_new); rsum += x0[i_] + x1[i_]; }
        l_run = l_run * alpha + rsum;
#pragma unroll
        for (int i_ = 0; i_ < 16; ++i_) { o0[i_] *= alpha; o1[i_] *= alpha; }
#pragma unroll
        for (int kb = 0; kb < 2; ++kb)
#pragma unroll
            for (int s = 0; s < 2; ++s) {
                u32x4 pw;
                if (kb == 0) { pw.x = pk2(x0[8 * s + 0], x0[8 * s + 1]); pw.y = pk2(x0[8 * s + 2], x0[8 * s + 3]); pw.z = pk2(x0[8 * s + 4], x0[8 * s + 5]); pw.w = pk2(x0[8 * s + 6], x0[8 * s + 7]); }
                else         { pw.x = pk2(x1[8 * s + 0], x1[8 * s + 1]); pw.y = pk2(x1[8 * s + 2], x1[8 * s + 3]); pw.z = pk2(x1[8 * s + 4], x1[8 * s + 5]); pw.w = pk2(x1[8 * s + 6], x1[8 * s + 7]); }
                const bf16x8 pb = __builtin_bit_cast(bf16x8, pw);
                const LAS unsigned char* vp = vread + (32 * kb + 16 * s) * VS;
                const s16x4 lo0 = __builtin_bit_cast(s16x4, __builtin_amdgcn_ds_read_tr16_b64_v4i16((LAS s16x4*)(vp)));
                const s16x4 hi0 = __builtin_bit_cast(s16x4, __builtin_amdgcn_ds_read_tr16_b64_v4i16((LAS s16x4*)(vp + 8 * VS)));
                const s16x4 lo1 = __builtin_bit_cast(s16x4, __builtin_amdgcn_ds_read_tr16_b64_v4i16((LAS s16x4*)(vp + 64)));
                const s16x4 hi1 = __builtin_bit_cast(s16x4, __builtin_amdgcn_ds_read_tr16_b64_v4i16((LAS s16x4*)(vp + 64 + 8 * VS)));
                const bf16x8 va0 = (bf16x8){lo0[0], lo0[1], lo0[2], lo0[3], hi0[0], hi0[1], hi0[2], hi0[3]};
                const bf16x8 va1 = (bf16x8){lo1[0], lo1[1], lo1[2], lo1[3], hi1[0], hi1[1], hi1[2], hi1[3]};
                o0 = __builtin_amdgcn_mfma_f32_32x32x16_bf16(va0, pb, o0, 0, 0, 0);
                o1 = __builtin_amdgcn_mfma_f32_32x32x16_bf16(va1, pb, o1, 0, 0, 0);
            }
        if (!last_chunk) { ++c; continue; }
        {
            const float l_tot = l_run + __shfl_xor(l_run, 32);
            const float inv = 1.0f / l_tot;
            const size_t tok = cur.tok0 + ((size_t)(cur.q0 + 32 * qh + r) << cur.sh);
            bf16_t* op = DIL ? ((cur.br == 2) ? (bf16_t*)(ws + WS_OP2) : (bf16_t*)(op01 + (size_t)cur.br * OP_BYTES)) : obuf;
            bf16_t* orow = op + tok * (DIL ? 512 : 1024) + (DIL ? cur.hsel * 256 : 512 + cur.hsel * 256) + hl * 64 + 4 * h;
#pragma unroll
            for (int g4 = 0; g4 < 4; ++g4) {
                u32x2 w0, w1;
                w0.x = pk2(o0[4 * g4 + 0] * inv, o0[4 * g4 + 1] * inv); w0.y = pk2(o0[4 * g4 + 2] * inv, o0[4 * g4 + 3] * inv);
                w1.x = pk2(o1[4 * g4 + 0] * inv, o1[4 * g4 + 1] * inv); w1.y = pk2(o1[4 * g4 + 2] * inv, o1[4 * g4 + 3] * inv);
                *(u32x2*)(orow + 8 * g4) = w0; *(u32x2*)(orow + 32 + 8 * g4) = w1;
            }
            if (DIL && h == 0) { float* lse = (float*)(ws + WS_LSE); lse[((size_t)cur.br * T + tok) * 8 + 4 * cur.hsel + hl] = m_run + __builtin_amdgcn_logf(l_tot); }
        }
        if (!has_next) break;
        i += G; cur = nxt; c = cur.c_lo;
#pragma unroll
        for (int s_ = 0; s_ < 4; ++s_) qf[s_] = qn[s_];
        ATT_INIT(cur);
        if (cur.hsel != hsel) {
            hsel = cur.hsel; __syncthreads();
            if (DIL) { att_fill_table(tb, rel, 1, hsel, tid); att_fill_table(tb, rel, 2, hsel, tid); att_fill_table(tb, rel, 3, hsel, tid); } else att_fill_table(tb, rel, 0, hsel, tid);
        }
    }
#undef ATT_COLS
#undef ATT_PREFETCH
#undef ATT_LOADQ
#undef ATT_INIT
}

struct Args { const float* in[16]; float* out; unsigned char* ws; int ph_lo, ph_hi, coop, pad; };
constexpr int LDS_BYTES = 147456;
constexpr int N_PHASES = 18;

__global__ void __launch_bounds__(512, 2) fwd_mega(Args args) {
    extern __shared__ __attribute__((aligned(16))) unsigned char lds_raw[];
    LAS unsigned char* lds = (LAS unsigned char*)lds_raw;
    cg::grid_group grid = cg::this_grid();
    const int ph_hi = args.ph_hi, coop = args.coop;
    if (threadIdx.x < 2) ((LAS unsigned*)(lds + LDS_BARST_OFF))[threadIdx.x] = 0u;
    __syncthreads();
    XcdBarrier xbar; xbar.bar = (unsigned*)(args.ws + WS_BAR); xbar.x = 0; xbar.st = (volatile LAS unsigned*)(lds + LDS_BARST_OFF);
    bool posted = false;
    for (int ph = args.ph_lo; ph < ph_hi; ++ph) {
        int tid = threadIdx.x; asm volatile("" : "+v"(tid));
        int bidx = blockIdx.x; asm volatile("" : "+s"(bidx));
        const __attribute__((address_space(4))) Args* ap = (const __attribute__((address_space(4))) Args*)__builtin_amdgcn_kernarg_segment_ptr(); asm volatile("" : "+s"(ap));
        const int lane = tid & 63, wave = __builtin_amdgcn_readfirstlane(tid >> 6);
        const int G = gridDim.x, gw = bidx * 8 + wave, NGW = G * 8;
        unsigned char* ws = ap->ws;
        float* ssb = (float*)(ws + WS_SS);
        bf16_t* XB = (bf16_t*)(ws + WS_XB); bf16_t* OB = (bf16_t*)(ws + WS_O); bf16_t* HB = (bf16_t*)(ws + WS_H);
        float* out = ap->out;
        if (ph == 0) {
            LAS float* scr = (LAS float*)(lds + wave * 16384);
            constexpr int I_GU = (DM / 64) * (FF / 32), I_DN = (FF / 64) * (DM / 32), I_IN = (DM / 64) * (NQKV / 32), I_WO = (DM / 64) * (DM / 32);
            constexpr int I_LAYER = 4 * I_GU + 2 * I_DN + I_IN + I_WO;
            for (int it = gw; it < 2 * I_LAYER; it += NGW) {
                const int l = it / I_LAYER; int rr = it % I_LAYER;
                unsigned char* wl = ws + WS_W + (size_t)l * WL_BYTES;
                if (rr < I_GU) { transpose_item(ap->in[4] + (size_t)l * DM * FF, DM, FF, ap->in[3] + l * DM, (bf16_t*)(wl + WL_W1A), 1, scr, rr, lane); continue; } rr -= I_GU;
                if (rr < I_GU) { transpose_item(ap->in[5] + (size_t)l * DM * FF, DM, FF, ap->in[3] + l * DM, (bf16_t*)(wl + WL_W1A), 2, scr, rr, lane); continue; } rr -= I_GU;
                if (rr < I_DN) { transpose_item(ap->in[6] + (size_t)l * FF * DM, FF, DM, nullptr, (bf16_t*)(wl + WL_W2A), 0, scr, rr, lane); continue; } rr -= I_DN;
                if (rr < I_GU) { transpose_item(ap->in[12] + (size_t)l * DM * FF, DM, FF, ap->in[11] + l * DM, (bf16_t*)(wl + WL_W1B), 1, scr, rr, lane); continue; } rr -= I_GU;
                if (rr < I_GU) { transpose_item(ap->in[13] + (size_t)l * DM * FF, DM, FF, ap->in[11] + l * DM, (bf16_t*)(wl + WL_W1B), 2, scr, rr, lane); continue; } rr -= I_GU;
                if (rr < I_DN) { transpose_item(ap->in[14] + (size_t)l * FF * DM, FF, DM, nullptr, (bf16_t*)(wl + WL_W2B), 0, scr, rr, lane); continue; } rr -= I_DN;
                if (rr < I_IN) { transpose_item(ap->in[8] + (size_t)l * DM * NQKV, DM, NQKV, ap->in[7] + l * DM, (bf16_t*)(wl + WL_WIN), 0, scr, rr, lane); continue; } rr -= I_IN;
                transpose_item(ap->in[9] + (size_t)l * DM * DM, DM, DM, nullptr, (bf16_t*)(wl + WL_WO), 0, scr, rr, lane);
            }
            for (int row = gw; row < T; row += NGW) {
                const float* src = (row >= TP) ? ap->in[1] + (size_t)(row - TP) * DM : ap->in[0] + (size_t)row * DM;
                const f32x4* xr = (const f32x4*)src + lane; f32x4 v[4]; float s = 0.f;
#pragma unroll
                for (int j = 0; j < 4; ++j) { v[j] = xr[64 * j]; s += (v[j][0] * v[j][0] + v[j][1] * v[j][1]) + (v[j][2] * v[j][2] + v[j][3] * v[j][3]); }
                s = wave_sum(s);
                u32x2* o8 = (u32x2*)(XB + (size_t)row * DM) + lane;
#pragma unroll
                for (int j = 0; j < 4; ++j) { u32x2 w; w.x = pk2(v[j][0], v[j][1]); w.y = pk2(v[j][2], v[j][3]); o8[64 * j] = w; }
                if (lane == 0) ssb[row] = s;
            }
            for (int i = bidx * 512 + tid; i < 6 * T; i += G * 512) ssb[T + i] = 0.f;
            if (bidx == 0) { unsigned* bw = (unsigned*)(ws + WS_BAR); for (int i = tid; i < XCD_BAR_WORDS; i += 512) bw[i] = 0u; }
        } else if (ph == N_PHASES - 1) {
            const float* ss = ssb + 6 * (size_t)T; const float* gf = ap->in[15];
            f32x4 gv[4];
#pragma unroll
            for (int j = 0; j < 4; ++j) gv[j] = ((const f32x4*)gf)[lane + 64 * j];
            for (int row = gw; row < T; row += NGW) {
                const float rs = __builtin_amdgcn_rsqf(ss[row] * (1.0f / 1024.0f) + EPS);
                f32x4* xr = (f32x4*)(out + (size_t)row * DM) + lane;
                if (true) {
#pragma unroll
                    for (int j = 0; j < 4; ++j) { f32x4 v = xr[64 * j]; v = v * rs * gv[j]; xr[64 * j] = v; }
                } else {
                    const u32x2* hr = (const u32x2*)(XB + (size_t)row * DM) + lane; u32x2 w[4];
#pragma unroll
                    for (int j = 0; j < 4; ++j) w[j] = hr[64 * j];
#pragma unroll
                    for (int j = 0; j < 4; ++j) { f32x4 v = (f32x4){__uint_as_float(w[j].x << 16), __uint_as_float(w[j].x & 0xffff0000u), __uint_as_float(w[j].y << 16), __uint_as_float(w[j].y & 0xffff0000u)};
                        v = v * rs * gv[j]; __builtin_nontemporal_store(v, xr + 64 * j); }
                }
            }
        } else {
            const int l = (ph - 1) >> 3, k = (ph - 1) & 7;
            const int rev = (k == 1 || k == 7 || k == 5) ? 1 : 0;
            unsigned char* wl = ws + WS_W + (size_t)l * WL_BYTES;
            if (k == 0 || k == 6) {
                const float* ss = ssb + (size_t)(3 * l + (k == 0 ? 0 : 2)) * T;
                if (SKEW1_TICKS > 0 && 2 * bidx >= G) { const unsigned long long t0 = __builtin_amdgcn_s_memrealtime(); while (__builtin_amdgcn_s_memrealtime() - t0 < (unsigned long long)SKEW1_TICKS) __builtin_amdgcn_s_sleep(8); }
                pg8::Gemm g{XB, (const bf16_t*)(wl + (k == 0 ? WL_W1A : WL_W1B)), T, 2 * FF, DM};
                pg8::StaticOrder S; S.init(T, 2 * FF, G, bidx, rev);
                pg8::EpiSwiGLU E{HB, ss};
                pg8::gemm_phase<pg8::EpiSwiGLU, pg8::StaticOrder>(lds, tid, g, S, E);
            } else if (k == 1 || k == 7 || k == 5) {
                const bool first = (l == 0 && k == 1), lastp = (l == 1 && k == 7);
                const float* sA = (XLO && first) ? ap->in[0] : nullptr; const float* sB = (XLO && first) ? ap->in[1] : nullptr;
                bf16_t* XL = XLO ? (bf16_t*)(ws + WS_XL) : (bf16_t*)nullptr;
                float* ssn = ssb + (size_t)(3 * l + (k == 1 ? 1 : (k == 5 ? 2 : 3))) * T;
                if (k == 5) {
                    pg8::Gemm g{OB, (const bf16_t*)(wl + WL_WO), T, DM, DM};
                    pg8::StaticOrder S; S.init(T, DM, G, bidx, rev);
                    pg8::EpiRes E{sA, sB, XB, XL, nullptr, ssn, 1.0f};
                    pg8::gemm_phase<pg8::EpiRes, pg8::StaticOrder>(lds, tid, g, S, E);
                } else {
                    pg8::Gemm g{HB, (const bf16_t*)(wl + (k == 1 ? WL_W2A : WL_W2B)), T, DM, FF};
                    pg8::StaticOrder S; S.init(T, DM, G, bidx, rev);
                    pg8::EpiRes E{sA, sB, XB, XL, lastp ? out : nullptr, ssn, 0.5f};
                    pg8::gemm_phase<pg8::EpiRes, pg8::StaticOrder>(lds, tid, g, S, E);
                }
            } else if (k == 2) {
                const float* ss = ssb + (size_t)(3 * l + 1) * T;
                pg8::Gemm g{XB, (const bf16_t*)(wl + WL_WIN), T, NQKV, DM};
                pg8::StaticOrder S; S.init(T, NQKV, G, bidx, rev);
                pg8::EpiQKV E{HB, ss};
                pg8::gemm_phase<pg8::EpiQKV, pg8::StaticOrder>(lds, tid, g, S, E);
            } else if (k == 3) {
                const float* rel = ap->in[2]; const float* sink = ap->in[10] + l * 8;
                {
                    const int vcu = (G % 8 == 0) ? (bidx % 8) * (G / 8) + bidx / 8 : bidx;
                    int iB = vcu, iD = vcu;
                    while (iD < 2560) iD += G;
                    attn_stream<false>(lds, tid, HB, rel, sink, OB, ws, (unsigned char*)out, iB, 2560, G, 0);
                    attn_stream<true>(lds, tid, HB, rel, sink, OB, ws, (unsigned char*)out, iD, 2560 + 7680, G, 2560);
                }
                __syncthreads();
            } else {
                const float* lse = (const float*)(ws + WS_LSE);
                const bf16_t* p0 = (const bf16_t*)out; const bf16_t* p1 = (const bf16_t*)((const unsigned char*)out + OP_BYTES); const bf16_t* p2 = (const bf16_t*)(ws + WS_OP2);
                for (size_t idx = (size_t)bidx * 512 + tid; idx < (size_t)T * 32; idx += (size_t)G * 512) {
                    const size_t tok = idx >> 5; const int hd = (int)(idx >> 2) & 7, c16 = (int)idx & 3;
                    const float l0 = lse[tok * 8 + hd], l1 = lse[((size_t)T + tok) * 8 + hd], l2 = lse[((size_t)2 * T + tok) * 8 + hd];
                    const size_t off = tok * 512 + hd * 64 + c16 * 16;
                    u32x4 a[2], bq[2], cq[2];
#pragma unroll
                    for (int e = 0; e < 2; ++e) { a[e] = *(const u32x4*)(p0 + off + 8 * e); bq[e] = *(const u32x4*)(p1 + off + 8 * e); cq[e] = *(const u32x4*)(p2 + off + 8 * e); }
                    const float mx = fmaxf(l0, fmaxf(l1, l2));
                    float w0 = __builtin_amdgcn_exp2f(l0 - mx), w1 = __builtin_amdgcn_exp2f(l1 - mx), w2 = __builtin_amdgcn_exp2f(l2 - mx);
                    const float inv = 1.0f / (w0 + w1 + w2); w0 *= inv; w1 *= inv; w2 *= inv;
#pragma unroll
                    for (int e = 0; e < 2; ++e) {
                        u32x4 o;
#pragma unroll
                        for (int j = 0; j < 4; ++j) {
                            const float a_lo = __uint_as_float(a[e][j] << 16), a_hi = __uint_as_float(a[e][j] & 0xffff0000u);
                            const float b_lo = __uint_as_float(bq[e][j] << 16), b_hi = __uint_as_float(bq[e][j] & 0xffff0000u);
                            const float c_lo = __uint_as_float(cq[e][j] << 16), c_hi = __uint_as_float(cq[e][j] & 0xffff0000u);
                            o[j] = pk2(w0 * a_lo + w1 * b_lo + w2 * c_lo, w0 * a_hi + w1 * b_hi + w2 * c_hi);
                        }
                        *(u32x4*)(OB + tok * 1024 + hd * 64 + c16 * 16 + 8 * e) = o;
                    }
                }
            }
        }
        if (ph + 1 < ph_hi && coop) {
            if (!posted) { grid.sync(); xbar = xcd_barrier_post((unsigned*)(args.ws + WS_BAR), (volatile LAS unsigned*)(lds + LDS_BARST_OFF)); posted = true; }
            else xcd_barrier(xbar);
        }
    }
}

extern "C" void kernel_launch(void* const* d_in, const int* in_sizes, int n_in, void* d_out, int out_size, void* d_ws, size_t ws_size, hipStream_t stream) {
    static int grid = 0;
    if (grid == 0) {
        if (n_in != 16 || out_size != T * DM || ws_size < WS_END) { fprintf(stderr, "kernel_launch: unexpected shapes (n_in %d out %d ws %zu)\n", n_in, out_size, ws_size); grid = -1; return; }
        int dev = 0, cus = 0, per_cu = 0;
        hipGetDevice(&dev); hipDeviceGetAttribute(&cus, hipDeviceAttributeMultiprocessorCount, dev);
        if (hipFuncSetAttribute((const void*)fwd_mega, hipFuncAttributeMaxDynamicSharedMemorySize, LDS_BYTES) != hipSuccess) { fprintf(stderr, "kernel_launch: hipFuncSetAttribute failed\n"); grid = -1; return; }
        if (hipOccupancyMaxActiveBlocksPerMultiprocessor(&per_cu, (const void*)fwd_mega, 512, LDS_BYTES) != hipSuccess || per_cu < 1) per_cu = 1;
        (void)hipGetLastError();
        grid = cus * per_cu;
    }
    if (grid < 0) return;
    Args a{};
    for (int i = 0; i < 16; ++i) a.in[i] = (const float*)d_in[i];
    a.out = (float*)d_out; a.ws = (unsigned char*)d_ws;
#if MK_PER_PHASE
    for (int ph = 0; ph < N_PHASES; ++ph) {
        a.ph_lo = ph; a.ph_hi = ph + 1; a.coop = 0;
        hipLaunchKernelGGL(fwd_mega, dim3(grid), dim3(512), LDS_BYTES, stream, a);
    }
#else
    a.ph_lo = 0; a.ph_hi = N_PHASES; a.coop = 1;
    void* kargs[] = {&a};
    hipError_t e = hipLaunchCooperativeKernel((const void*)fwd_mega, dim3(grid), dim3(512), kargs, LDS_BYTES, stream);
    if (e != hipSuccess) fprintf(stderr, "cooperative launch failed: %s (grid %d)\n", hipGetErrorString(e), grid);
#endif
}
```
